# Optimizing an MI355X kernel written in HIP

```python
import jax
import jax.numpy as jnp
from jax import lax
import numpy as np

D_MODEL = 2048
BATCH = 4
SEQ = 4096
DEPTH = 4

D_HGRN = D_MODEL // 2
HGRN_HEAD_DIM = 128
HGRN_HEADS = D_HGRN // HGRN_HEAD_DIM
D_POOL = D_MODEL - D_HGRN
POOL_WINDOWS = (2, 4, 8, 16)
POOL_GROUPS = len(POOL_WINDOWS)
POOL_GROUP_DIM = D_POOL // POOL_GROUPS
D_MIX = D_HGRN + D_POOL
D_IN = 4 * D_HGRN + D_POOL
D_FF = ((8 * D_MODEL // 3 + 255) // 256) * 256
CONV_WIDTH = 3
CHUNK = 64
N_MOD = 6
EPS = 1e-6

kernel_name = 'hymba_style_hgrn2_pool_hybrid'


def rms_norm(x, gain):
    xf = x.astype(jnp.float32)
    y = xf * lax.rsqrt(jnp.mean(xf * xf, axis=-1, keepdims=True) + EPS)
    return (y * gain.astype(jnp.float32)).astype(x.dtype)


def hgrn2_chunked(q, k, v, log_f):
    B, S, H, Dk = q.shape
    Dv = v.shape[-1]
    n = S // CHUNK

    def to_chunks(t):
        return t.reshape(B, n, CHUNK, H, t.shape[-1]).transpose(1, 0, 3, 2, 4)

    qc, kc, vc, gc = (to_chunks(t) for t in (q, k, v, log_f))
    causal = jnp.tril(jnp.ones((CHUNK, CHUNK), dtype=bool))[:, :, None]

    def step(state, inp):
        qn, kn, vn, gn = inp
        b = jnp.cumsum(gn, axis=-2)
        diff = b[:, :, :, None, :] - b[:, :, None, :, :]
        decay = jnp.where(causal, jnp.exp(jnp.where(causal, diff, 0.0)), 0.0)
        scores = jnp.einsum('bhtd,bhsd,bhtsd->bhts', qn, kn, decay)
        o = (jnp.einsum('bhts,bhsv->bhtv', scores, vn)
             + jnp.einsum('bhtd,bhdv->bhtv', qn * jnp.exp(b), state))
        b_last = b[:, :, -1:, :]
        state = (jnp.exp(b_last[:, :, 0, :, None]) * state
                 + jnp.einsum('bhsd,bhsv->bhdv', kn * jnp.exp(b_last - b), vn))
        return state, o

    s0 = jnp.zeros((B, H, Dk, Dv), jnp.float32)
    _, o = lax.scan(step, s0, (qc, kc, vc, gc))
    return o.transpose(1, 0, 3, 2, 4).reshape(B, S, H, Dv)


def hgrn2_branch(q, f, i, g, lb, norm_g):
    B, S, _ = q.shape

    def heads(t):
        return t.astype(jnp.float32).reshape(B, S, HGRN_HEADS, HGRN_HEAD_DIM)

    qh = heads(jax.nn.silu(q)) * (HGRN_HEAD_DIM ** -0.5)
    z = heads(f)
    lbh = lb.astype(jnp.float32).reshape(HGRN_HEADS, HGRN_HEAD_DIM)
    log_f = jax.nn.log_sigmoid(z) + jnp.log1p(lbh * jnp.exp(-z))
    kh = (1.0 - lbh) * jax.nn.sigmoid(-z)
    o = hgrn2_chunked(qh, kh, heads(i), log_f)
    o = rms_norm(o, norm_g).reshape(B, S, D_HGRN)
    return (o * jax.nn.silu(g.astype(jnp.float32))).astype(q.dtype)


def pool_branch(u, pool_w, pool_scale):
    B, S, _ = u.shape
    uf = u.astype(jnp.float32).reshape(B, S, POOL_GROUPS, POOL_GROUP_DIM)
    cs = jnp.pad(jnp.cumsum(uf, axis=1), ((0, 0), (1, 0), (0, 0), (0, 0)))
    counts_base = jnp.arange(1, S + 1, dtype=jnp.float32)
    means = []
    for gi, w in enumerate(POOL_WINDOWS):
        csg = cs[:, :, gi]
        prev = jnp.pad(csg, ((0, 0), (w - 1, 0), (0, 0)))[:, :S]
        count = jnp.minimum(counts_base, float(w))
        means.append((csg[:, 1:] - prev) / count[None, :, None])
    pooled = jnp.stack(means, axis=2) - uf
    y = jnp.einsum('bsgd,gde->bsge', pooled, pool_w.astype(jnp.float32)).reshape(B, S, D_POOL)
    return (y * pool_scale.astype(jnp.float32)).astype(u.dtype)


def conv_glu(h, w_up, conv_w, conv_b, w_down):
    a, v = jnp.split(h @ w_up, 2, axis=-1)
    S = a.shape[1]
    ap = jnp.pad(a, ((0, 0), (CONV_WIDTH - 1, 0), (0, 0)))
    conv = conv_b
    for tap in range(CONV_WIDTH):
        conv = conv + conv_w[tap] * ap[:, tap:tap + S]
    return (jax.nn.silu(conv) * v) @ w_down


def setup_inputs(seed: int = 0):
    key = jax.random.key(seed)
    ks = jax.random.split(key, 17)
    f32 = jnp.float32

    def nrm(k, shape, scale):
        return jax.random.normal(k, shape, f32) * scale

    def gain(k, shape):
        return 1.0 + 0.02 * jax.random.normal(k, shape, f32)

    return {
        'x': nrm(ks[0], (BATCH, SEQ, D_MODEL), 1.0),
        'c': nrm(ks[1], (BATCH, D_MODEL), 1.0),
        'ada_w': nrm(ks[2], (DEPTH, D_MODEL, N_MOD * D_MODEL), 0.5 * D_MODEL ** -0.5),
        'ada_b': nrm(ks[3], (DEPTH, N_MOD * D_MODEL), 0.01),
        'mix_norm_g': gain(ks[4], (DEPTH, D_MODEL)),
        'w_in': nrm(ks[5], (DEPTH, D_MODEL, D_IN), D_MODEL ** -0.5),
        'hgrn_lower_bounds': nrm(ks[6], (DEPTH, D_HGRN), 0.1),
        'hgrn_norm_g': gain(ks[7], (DEPTH, HGRN_HEAD_DIM)),
        'pool_w': nrm(ks[8], (DEPTH, POOL_GROUPS, POOL_GROUP_DIM, POOL_GROUP_DIM), POOL_GROUP_DIM ** -0.5),
        'pool_scale': gain(ks[9], (DEPTH, D_POOL)),
        'w_out': nrm(ks[10], (DEPTH, D_MIX, D_MODEL), D_MIX ** -0.5),
        'ffn_norm_g': gain(ks[11], (DEPTH, D_MODEL)),
        'w_up': nrm(ks[12], (DEPTH, D_MODEL, 2 * D_FF), D_MODEL ** -0.5),
        'conv_w': nrm(ks[13], (DEPTH, CONV_WIDTH, D_FF), CONV_WIDTH ** -0.5),
        'conv_b': nrm(ks[14], (DEPTH, D_FF), 0.01),
        'w_down': nrm(ks[15], (DEPTH, D_FF, D_MODEL), D_FF ** -0.5),
        'final_norm_g': gain(ks[16], (D_MODEL,)),
    }


def reference(x, c, ada_w, ada_b, mix_norm_g, w_in, hgrn_lower_bounds, hgrn_norm_g, pool_w,
              pool_scale, w_out, ffn_norm_g, w_up, conv_w, conv_b, w_down, final_norm_g):
    p = jax.nn.softmax(hgrn_lower_bounds.astype(jnp.float32), axis=0)
    lower_bounds = jnp.clip(jnp.cumsum(p, axis=0) - p[0:1], 0.0, 1.0)
    c_act = jax.nn.silu(c)
    for l in range(DEPTH):
        mod = (c_act @ ada_w[l] + ada_b[l])[:, None, :]
        shift1, scale1, gate1, shift2, scale2, gate2 = jnp.split(mod, N_MOD, axis=-1)

        h = rms_norm(x, mix_norm_g[l]) * (1.0 + scale1) + shift1
        proj = h @ w_in[l]
        q, f, i, g, u = jnp.split(proj, [D_HGRN, 2 * D_HGRN, 3 * D_HGRN, 4 * D_HGRN], axis=-1)
        y_a = hgrn2_branch(q, f, i, g, lower_bounds[l], hgrn_norm_g[l])
        y_b = pool_branch(u, pool_w[l], pool_scale[l])
        x = x + gate1 * (jnp.concatenate([y_a, y_b], axis=-1) @ w_out[l])

        h = rms_norm(x, ffn_norm_g[l]) * (1.0 + scale2) + shift2
        x = x + gate2 * conv_glu(h, w_up[l], conv_w[l], conv_b[l], w_down[l])
    return rms_norm(x, final_norm_g)
```

```cpp
#include <hip/hip_runtime.h>
#include <stdint.h>
#include <stdio.h>

namespace cfg {
constexpr int D = 2048, NB = 4, SEQ = 4096, L = 4, M = NB * SEQ;
constexpr int DH = 1024, HD = 128, NH = 8, DP = 1024, DIN = 5120, DFF = 5632, NUP = 11264, CH = 64, NCH = SEQ / CH;
constexpr float EPS = 1e-6f;
constexpr float QSCALE = 0.08838834764831845f;
}
using namespace cfg;

typedef unsigned short bf16_t;
typedef short bf16x8 __attribute__((ext_vector_type(8)));
typedef float f32x4 __attribute__((ext_vector_type(4)));
typedef unsigned u32x4 __attribute__((ext_vector_type(4)));
typedef unsigned u32x2 __attribute__((ext_vector_type(2)));

__device__ __forceinline__ bf16_t f2bf(float f) { unsigned u = __float_as_uint(f); u += 0x7fffu + ((u >> 16) & 1u); return (bf16_t)(u >> 16); }
__device__ __forceinline__ float bf2f(bf16_t b) { return __uint_as_float(((unsigned)b) << 16); }
__device__ __forceinline__ unsigned pk2(float lo, float hi) { return (unsigned)f2bf(lo) | ((unsigned)f2bf(hi) << 16); }
typedef float f32x2_t __attribute__((ext_vector_type(2)));
typedef __bf16 bf16x2_t __attribute__((ext_vector_type(2)));
__device__ __forceinline__ unsigned cvt_pk_bf16_c(float lo, float hi) { const f32x2_t v = {lo, hi}; return __builtin_bit_cast(unsigned, __builtin_convertvector(v, bf16x2_t)); }
__device__ __forceinline__ unsigned cvt_pk_bf16(float lo, float hi) { unsigned r; asm volatile("v_cvt_pk_bf16_f32 %0, %1, %2" : "=v"(r) : "v"(lo), "v"(hi)); return r; }
__device__ __forceinline__ float bperm(float v, int src_lane) { return __int_as_float(__builtin_amdgcn_ds_bpermute(src_lane << 2, __float_as_int(v))); }
__device__ __forceinline__ float siluf(float x) { return x * __builtin_amdgcn_rcpf(1.f + __expf(-x)); }
__device__ __forceinline__ float logf_of(float p, float lb) { const float sig = __builtin_amdgcn_rcpf(1.f + __expf(-p)); const float f = lb + (1.f - lb) * sig; return fmaxf(__logf(f), -60.f); }

constexpr size_t al256(size_t x) { return (x + 255) & ~(size_t)255; }
constexpr size_t O_CTL = 0, SZ_CTL = 1u << 20;
constexpr size_t O_MOD = O_CTL + SZ_CTL,                 SZ_MOD = (size_t)L * NB * 6 * D * 4;
constexpr size_t O_LB = O_MOD + al256(SZ_MOD),           SZ_LB = (size_t)L * DH * 4;
constexpr size_t O_GS1 = O_LB + al256(SZ_LB),            SZ_GS = (size_t)L * NB * D * 4;
constexpr size_t O_GS2 = O_GS1 + al256(SZ_GS);
constexpr size_t O_SW1 = O_GS2 + al256(SZ_GS),           SZ_SW1 = (size_t)L * NB * DIN * 4;
constexpr size_t O_SW2 = O_SW1 + al256(SZ_SW1),          SZ_SW2 = (size_t)L * NB * NUP * 4;
constexpr size_t O_RSS1 = O_SW2 + al256(SZ_SW2),         SZ_RSS = (size_t)M * 32 * 4;
constexpr size_t O_RSS2 = O_RSS1 + al256(SZ_RSS);
constexpr size_t O_WTIN = O_RSS2 + al256(SZ_RSS),        SZ_WTIN = (size_t)L * DIN * D * 2;
constexpr size_t O_WTOUT = O_WTIN + al256(SZ_WTIN),      SZ_WTOUT = (size_t)L * D * D * 2;
constexpr size_t O_WTUP = O_WTOUT + al256(SZ_WTOUT),     SZ_WTUP = (size_t)L * NUP * D * 2;
constexpr size_t O_WTDN = O_WTUP + al256(SZ_WTUP),       SZ_WTDN = (size_t)L * D * DFF * 2;
constexpr size_t O_WTPL = O_WTDN + al256(SZ_WTDN),       SZ_WTPL = (size_t)L * 4 * 256 * 256 * 2;
constexpr size_t O_X = O_WTPL + al256(SZ_WTPL),          SZ_X = (size_t)M * D * 4;
constexpr size_t O_XS = O_X + al256(SZ_X),               SZ_XS = (size_t)M * D * 2;
constexpr size_t O_ACT = O_XS + al256(SZ_XS),            SZ_ACT = (size_t)M * DFF * 2;
constexpr size_t O_HA = O_ACT + al256(SZ_ACT),           SZ_HA = (size_t)256 * 4 * DFF * 4;
constexpr size_t O_HV = O_HA + al256(SZ_HA),             SZ_HV = (size_t)256 * 2 * DFF * 4;
constexpr size_t O_MODP = O_HV + al256(SZ_HV),           SZ_MODP = (size_t)32 * L * NB * 6 * D * 4;
constexpr size_t O_MIX = O_MODP + al256(SZ_MODP);
constexpr size_t SZ_H16 = (size_t)M * DH * 2;
constexpr size_t O_Q = O_MIX, O_V = O_Q + SZ_H16, O_SG = O_V + SZ_H16, O_U = O_SG + SZ_H16, O_PU = O_U + SZ_H16;
constexpr size_t O_LF = O_PU + SZ_H16,                   SZ_LF = (size_t)M * DH * 4;
constexpr size_t O_YAB = O_LF + SZ_LF,                   SZ_YAB = (size_t)M * D * 2;
constexpr size_t O_DS = O_YAB + SZ_YAB,                  SZ_DS = (size_t)NB * NH * NCH * HD * HD * 2;
constexpr size_t O_DEC = O_DS + SZ_DS,                   SZ_DEC = (size_t)NB * NH * NCH * HD * 4;
constexpr size_t O_MIXEND = O_DEC + al256(SZ_DEC);
constexpr size_t WS_END = O_MIXEND;
static_assert(WS_END < (size_t)1470 * 1000 * 1000, "workspace map exceeds the guaranteed d_ws size");

__host__ __device__ __forceinline__ int up_rowmap(int n) { return n < DFF ? 256 * (n / 128) + (n % 128) : 256 * ((n - DFF) / 128) + 128 + ((n - DFF) % 128); }

__device__ __forceinline__ int lane_id_opaque() { int l; asm volatile("v_mbcnt_lo_u32_b32 %0, -1, 0\n\tv_mbcnt_hi_u32_b32 %0, -1, %0" : "=v"(l)); return l; }
namespace pg8 {
#define PG8_LAS __attribute__((address_space(3)))
constexpr int BM = 256, BK = 64, HALF = 128, HTB = HALF * BK * 2  , STAGE_BYTES = 8 * HTB, NXCD = 8;
__host__ __device__ __forceinline__ int lds_byte(int r, int c) { const int st = (r >> 4) * 2 + (c >> 5), rr = r & 15, cc = c & 31, ob = rr * 64 + cc * 2; return st * 1024 + (ob ^ (((ob >> 9) & 1) << 5)); }
__host__ __device__ __forceinline__ void stage_rc(int b, int& R, int& C) { const int st = b / 1024, sb = b % 1024, swz = sb ^ (((sb >> 9) & 1) << 5); R = (st >> 1) * 16 + swz / 64; C = (st & 1) * 32 + (swz % 64) / 2; }
__host__ __device__ __forceinline__ int perm32(int rho) { const int n = rho >> 4, i = rho & 15; return 8 * (i >> 2) + 4 * n + (i & 3); }

struct Unit { int pm, pn; };
struct Gemm { const bf16_t* A; const bf16_t* Bt; };

struct StaticOrder {
    int nM, nN, nwg, G, c, WGM;
    __host__ __device__ void init(int M, int N, int G_, int c_, int wgm = 8) { nM = M / BM; nN = N / BM; nwg = nM * nN; G = G_; c = c_; WGM = wgm; }
    __host__ __device__ bool next(int i, Unit& u) const {
        const long Lx = (long)i * G + c; if (Lx >= nwg) return false;
        int wgid = (int)Lx; { const int q = nwg / NXCD, r = nwg % NXCD, xcd = wgid % NXCD, off = wgid / NXCD; wgid = (xcd < r ? xcd * (q + 1) : r * (q + 1) + (xcd - r) * q) + off; }
        const int nig = WGM * nN, gid = wgid / nig, fm = gid * WGM, gsz = (nM - fm) < WGM ? (nM - fm) : WGM;
        u.pm = fm + ((wgid % nig) % gsz); u.pn = (wgid % nig) / gsz; return true;
    }
    __device__ __forceinline__ size_t b_off(const Unit&) const { return 0; }
    __device__ __forceinline__ void a_ready(const Unit&) const {}
    __device__ __forceinline__ void done(const Unit&) const {}
};

struct InOrder {
    int vid, G;
    __host__ __device__ __forceinline__ void init(int G_, int c) { G = G_; vid = (G_ % 8 == 0) ? (c % 8) * (G_ / 8) + c / 8 : c; }
    __host__ __device__ __forceinline__ bool next(int i, Unit& u) const { const int vv = vid + (i / 5) * G; if (vv >= 256) return false; u.pm = vv >> 2; u.pn = (vv & 3) + 4 * (i % 5); return true; }
    __device__ __forceinline__ size_t b_off(const Unit&) const { return 0; }
    __device__ __forceinline__ void a_ready(const Unit&) const {}
    __device__ __forceinline__ void done(const Unit&) const {}
    __host__ __device__ __forceinline__ int item(int k) const { const int vv = vid + (k >> 3) * G; if (vv >= 256) return -1; const int pm = vv >> 2, p = vv & 3, j = k & 7; return (((pm >> 4) * 8 + 2 * p + (j >> 2)) << 6) + (pm & 15) * 4 + (j & 3); }
};
struct NoPre { __device__ __forceinline__ void operator()() const {} };
template <class Epi, class Sched, int LDA, int LDB, int KK, int APN, bool ALIGN_EPI = false, bool SP2 = false, bool ROWP = false, class Pre = NoPre, long KSA = 0, long TSA = 0, bool KREV = false, long KSB = 0, long TSB = 0>
__device__ __forceinline__ void gemm_phase(PG8_LAS unsigned char* lds, const Gemm g, const Sched& S, const Epi& E, int tid_in, const Pre& P = Pre()) {
    int tid_o = tid_in; asm volatile("" : "+v"(tid_o));
    const int tid = tid_o, wid = __builtin_amdgcn_readfirstlane(tid >> 6), lane = tid & 63, wr = wid >> 2, wc = wid & 3, fr = lane & 15, fq = lane >> 4;
    constexpr int nt = KK / BK;
    unsigned voffA[2], voffB[2];
#pragma unroll
    for (int i = 0; i < 2; ++i) { int R, C; stage_rc(tid * 16 + i * 8192, R, C); const int Rb = Epi::PERM ? ((R & ~31) + perm32(R & 31)) : R;
        const int Ra = ROWP ? (128 * (R >> 6) + 8 * (R & 15) + ((R >> 4) & 3)) : R;
        voffA[i] = (unsigned)(Ra * LDA + C) * 2u; voffB[i] = (unsigned)(Rb * LDB + C) * 2u; }
    constexpr ptrdiff_t kstep0 = KSB ? (ptrdiff_t)KSB : (ptrdiff_t)(BK * 2), kstepA0 = KSA ? (ptrdiff_t)KSA : (ptrdiff_t)(BK * 2), kstep = KREV ? -kstep0 : kstep0, kstepA = KREV ? -kstepA0 : kstepA0;
    constexpr ptrdiff_t kofB = KREV ? (ptrdiff_t)(KK / BK - 1) * kstep0 : 0, kofA = KREV ? (ptrdiff_t)(KK / BK - 1) * kstepA0 : 0;
    constexpr size_t hstepA = (size_t)(ROWP ? 4 : HALF) * LDA * 2, hstepB = (size_t)HALF * LDB * 2;
    constexpr size_t tstepA = TSA ? (size_t)TSA : (size_t)2 * HALF * LDA * 2, tstepB = TSB ? (size_t)TSB : 2 * hstepB;
    const unsigned ldsw = (unsigned)wid * 1024u;
    const int aoff = lds_byte(wr * 64 + fr, fq * 8), boff = lds_byte(wc * 32 + fr, fq * 8);
#define PG8_SA(b, h) (((b) * 2 + (h)) * HTB)
#define PG8_SB(b, h) ((4 + (b) * 2 + (h)) * HTB)
#define PG8_STAGE(bufoff, gbase, voff) do { _Pragma("unroll") for (int _i = 0; _i < 2; ++_i) \
        __builtin_amdgcn_global_load_lds((const unsigned*)((const char*)(gbase) + (voff)[_i]), (PG8_LAS unsigned*)(lds + (bufoff) + ldsw + _i * 8192), 16, 0, 0); } while (0)
#define PG8_LDA(dst, b, h) do { _Pragma("unroll") for (int m = 0; m < 4; ++m) _Pragma("unroll") for (int k = 0; k < 2; ++k) dst[m][k] = *(const PG8_LAS bf16x8*)(lds + PG8_SA(b, h) + aoff + m * 2048 + k * 1024); } while (0)
#define PG8_LDB(dst, b, h) do { _Pragma("unroll") for (int n = 0; n < 2; ++n) _Pragma("unroll") for (int k = 0; k < 2; ++k) dst[n][k] = *(const PG8_LAS bf16x8*)(lds + PG8_SB(b, h) + boff + n * 2048 + k * 1024); } while (0)
#define PG8_MMA(ai, bj, At, Bt) do { __builtin_amdgcn_s_setprio(1); _Pragma("unroll") for (int m = 0; m < 4; ++m) _Pragma("unroll") for (int n = 0; n < 2; ++n) _Pragma("unroll") for (int k = 0; k < 2; ++k) \
        acc[ai][bj][m][n] = __builtin_amdgcn_mfma_f32_16x16x32_bf16(Bt[n][k], At[m][k], acc[ai][bj][m][n], 0, 0, 0); __builtin_amdgcn_s_setprio(0); } while (0)
#define PG8_WAIT_V(n) asm volatile("s_waitcnt vmcnt(" #n ")" ::: "memory")
#define PG8_WAIT_L(n) asm volatile("s_waitcnt lgkmcnt(" #n ")" ::: "memory")
#define PG8_BAR __builtin_amdgcn_s_barrier()
#define PG8_SCHED __builtin_amdgcn_sched_barrier(0)
    Unit cur, nxt; int ui = 0;
    if (!S.next(0, cur)) return;
    f32x4 acc[2][2][4][2];
#pragma unroll
    for (int a = 0; a < 2; ++a)
#pragma unroll
        for (int b = 0; b < 2; ++b)
#pragma unroll
            for (int m = 0; m < 4; ++m)
#pragma unroll
                for (int n = 0; n < 2; ++n) acc[a][b][m][n] = (f32x4){0.f, 0.f, 0.f, 0.f};
    bf16x8 At[4][2], B0[2][2], B1[2][2];
    const char* cA = (const char*)g.A + (size_t)cur.pm * tstepA + (size_t)cur.pn * APN + kofA; const char* cB = (const char*)g.Bt + (size_t)cur.pn * tstepB + S.b_off(cur) + kofB;
    S.a_ready(cur);
    if constexpr (SP2) {
        PG8_STAGE(PG8_SB(0, 0), cB, voffB); PG8_STAGE(PG8_SB(0, 1), cB + hstepB, voffB); PG8_STAGE(PG8_SA(0, 0), cA, voffA); PG8_STAGE(PG8_SA(0, 1), cA + hstepA, voffA);
        P();
        if (wr == 1) PG8_BAR;
        PG8_WAIT_V(2); PG8_BAR;
        PG8_STAGE(PG8_SB(1, 0), cB + kstep, voffB); PG8_STAGE(PG8_SA(1, 0), cA + kstepA, voffA); PG8_STAGE(PG8_SB(1, 1), cB + hstepB + kstep, voffB);
        PG8_WAIT_V(6); PG8_BAR;
    } else {
        PG8_STAGE(PG8_SB(0, 0), cB, voffB); PG8_STAGE(PG8_SA(0, 0), cA, voffA); PG8_STAGE(PG8_SB(0, 1), cB + hstepB, voffB); PG8_STAGE(PG8_SA(0, 1), cA + hstepA, voffA);
        if (wr == 1) PG8_BAR;
        PG8_WAIT_V(4); PG8_BAR;
        PG8_STAGE(PG8_SB(1, 0), cB + kstep, voffB); PG8_STAGE(PG8_SA(1, 0), cA + kstepA, voffA); PG8_STAGE(PG8_SB(1, 1), cB + hstepB + kstep, voffB);
        PG8_WAIT_V(6); PG8_BAR;
    }
    for (;;) {
        const bool has_next = S.next(ui + 1, nxt);
        const char* nA = has_next ? (const char*)g.A + (size_t)nxt.pm * tstepA + (size_t)nxt.pn * APN + kofA : cA; const char* nB = has_next ? (const char*)g.Bt + (size_t)nxt.pn * tstepB + S.b_off(nxt) + kofB : cB;
        for (int t = 0; t < nt; t += 2) {
            const bool last = (t == nt - 2);
            const char* a1 = cA + (ptrdiff_t)(t + 1) * kstepA;
            const char* a2 = last ? nA : cA + (ptrdiff_t)(t + 2) * kstepA; const char* b2 = last ? nB : cB + (ptrdiff_t)(t + 2) * kstep;
            const char* a3 = a2 + kstepA; const char* b3 = b2 + kstep;
            if (last && has_next) S.a_ready(nxt);
            if constexpr (SP2) {
            PG8_LDB(B0, 0, 0); PG8_LDB(B1, 0, 1); PG8_SCHED; PG8_LDA(At, 0, 0); PG8_STAGE(PG8_SA(1, 1), a1 + hstepA, voffA);
            PG8_WAIT_V(8); PG8_WAIT_L(0); PG8_BAR; PG8_MMA(0, 0, At, B0); PG8_MMA(0, 1, At, B1); PG8_BAR; PG8_SCHED;
            PG8_LDA(At, 0, 1); PG8_STAGE(PG8_SB(0, 0), b2, voffB); PG8_STAGE(PG8_SB(0, 1), b2 + hstepB, voffB); PG8_STAGE(PG8_SA(0, 0), a2, voffA);
            PG8_WAIT_V(8); PG8_WAIT_L(0); PG8_BAR; PG8_MMA(1, 0, At, B0); PG8_MMA(1, 1, At, B1); PG8_BAR; PG8_SCHED;
            PG8_LDB(B0, 1, 0); PG8_LDB(B1, 1, 1); PG8_SCHED; PG8_LDA(At, 1, 0); PG8_STAGE(PG8_SA(0, 1), a2 + hstepA, voffA);
            PG8_WAIT_V(8); PG8_WAIT_L(0); PG8_BAR; PG8_MMA(0, 0, At, B0); PG8_MMA(0, 1, At, B1); PG8_BAR; PG8_SCHED;
            PG8_LDA(At, 1, 1); PG8_STAGE(PG8_SB(1, 0), b3, voffB); PG8_STAGE(PG8_SB(1, 1), b3 + hstepB, voffB); PG8_STAGE(PG8_SA(1, 0), a3, voffA);
            PG8_WAIT_V(8); PG8_WAIT_L(0); PG8_BAR; PG8_MMA(1, 0, At, B0); PG8_MMA(1, 1, At, B1); PG8_BAR; PG8_SCHED;
            } else {
            PG8_LDB(B0, 0, 0); PG8_SCHED; PG8_LDA(At, 0, 0); PG8_STAGE(PG8_SA(1, 1), a1 + hstepA, voffA);
            PG8_WAIT_L(8); PG8_BAR; PG8_WAIT_L(0); PG8_MMA(0, 0, At, B0); PG8_BAR; PG8_SCHED;
            PG8_LDB(B1, 0, 1); PG8_STAGE(PG8_SB(0, 0), b2, voffB);
            PG8_BAR; PG8_WAIT_L(0); PG8_MMA(0, 1, At, B1); PG8_BAR;
            PG8_LDA(At, 0, 1); PG8_STAGE(PG8_SA(0, 0), a2, voffA);
            PG8_BAR; PG8_WAIT_L(0); PG8_MMA(1, 0, At, B0); PG8_BAR; PG8_SCHED;
            PG8_STAGE(PG8_SB(0, 1), b2 + hstepB, voffB);
            PG8_WAIT_V(6); PG8_BAR; PG8_MMA(1, 1, At, B1); PG8_BAR;
            PG8_LDB(B0, 1, 0); PG8_SCHED; PG8_LDA(At, 1, 0); PG8_STAGE(PG8_SA(0, 1), a2 + hstepA, voffA);
            PG8_WAIT_L(8); PG8_BAR; PG8_WAIT_L(0); PG8_MMA(0, 0, At, B0); PG8_BAR; PG8_SCHED;
            PG8_LDB(B1, 1, 1); PG8_STAGE(PG8_SB(1, 0), b3, voffB);
            PG8_BAR; PG8_WAIT_L(0); PG8_MMA(0, 1, At, B1); PG8_BAR;
            PG8_LDA(At, 1, 1); PG8_STAGE(PG8_SA(1, 0), a3, voffA);
            PG8_BAR; PG8_WAIT_L(0); PG8_MMA(1, 0, At, B0); PG8_BAR; PG8_SCHED;
            PG8_STAGE(PG8_SB(1, 1), b3 + hstepB, voffB);
            PG8_WAIT_V(6); PG8_BAR; PG8_MMA(1, 1, At, B1); PG8_BAR;
            }
        }
        if constexpr (ALIGN_EPI) { if (wr == 0) PG8_BAR; }
        { const int l2 = lane_id_opaque(); E(acc, cur, ui, wr, wc, l2 & 15, l2 >> 4); }
        S.done(cur);
        if (!has_next) break;
#pragma unroll
        for (int a = 0; a < 2; ++a)
#pragma unroll
            for (int b = 0; b < 2; ++b)
#pragma unroll
                for (int m = 0; m < 4; ++m)
#pragma unroll
                    for (int n = 0; n < 2; ++n) acc[a][b][m][n] = (f32x4){0.f, 0.f, 0.f, 0.f};
        cur = nxt; cA = nA; cB = nB; ++ui;
        if constexpr (ALIGN_EPI) { if (wr == 1) PG8_BAR; }
    }
    PG8_WAIT_V(0);
    if constexpr (!ALIGN_EPI) { if (wr == 0) PG8_BAR; }
    PG8_BAR;
#undef PG8_SA
#undef PG8_SB
#undef PG8_STAGE
#undef PG8_LDA
#undef PG8_LDB
#undef PG8_MMA
#undef PG8_WAIT_V
#undef PG8_WAIT_L
#undef PG8_BAR
#undef PG8_SCHED
}
}

#ifndef PG8_SP2
#define PG8_SP2 true
#endif
#ifndef PG8_ALIGN
#define PG8_ALIGN true
#endif

#define LAS __attribute__((address_space(3)))
constexpr int RSTD_OFF = 131072 + 1024;
template <class Sched> __device__ __forceinline__ void fill_rstd(LAS unsigned char* lds, const float* RSS, const Sched& S, int tid) {
    LAS float* T = (LAS float*)(lds + RSTD_OFF); const int row = tid & 255; pg8::Unit u;
    int prev_pm = -1; float prev = 0.f;
    for (int i = tid >> 8; S.next(i, u); i += 2) {
        if (u.pm != prev_pm) { const float* p = RSS + (size_t)(u.pm * 256 + row) * 32; float s_ = 0.f;
#pragma unroll
            for (int j = 0; j < 8; ++j) { const f32x4 a = *(const f32x4*)(p + 4 * j); s_ += (a.x + a.y) + (a.z + a.w); }
            prev = rsqrtf(s_ * (1.f / D) + EPS); prev_pm = u.pm; }
        T[i * 256 + row] = prev; }
    __syncthreads();
}
template <class Sched> struct FillRstd { LAS unsigned char* lds; const float* RSS; const Sched* S; int tid;
    __device__ __forceinline__ void operator()() const { fill_rstd(lds, RSS, *S, tid); } };
__device__ __forceinline__ u32x4 pack8(const f32x4 a, const f32x4 b) { u32x4 w; w.x = cvt_pk_bf16(a.x, a.y); w.y = cvt_pk_bf16(a.z, a.w); w.z = cvt_pk_bf16(b.x, b.y); w.w = cvt_pk_bf16(b.z, b.w); return w; }
__device__ __forceinline__ f32x4 silu4(const f32x4 p) { f32x4 r; r.x = siluf(p.x); r.y = siluf(p.y); r.z = siluf(p.z); r.w = siluf(p.w); return r; }

typedef _Float16 f16x8_t __attribute__((ext_vector_type(8)));
typedef float f32x8_t __attribute__((ext_vector_type(8)));
__host__ __device__ __forceinline__ size_t xs_off(int row, int col) { return (size_t)(row >> 8) * (256 * D) + (size_t)(col >> 6) * (256 * 64) + (size_t)((row & 255) * 64 + (col & 63)); }
struct EpiIn {
    static constexpr bool PERM = true;
    const LAS float* RSTD; const float* SW; const float* LBl; bf16_t *Q, *V, *SG, *U; _Float16* LF;
    __device__ __forceinline__ void operator()(f32x4 (&acc)[2][2][4][2], const pg8::Unit& u, int ui, int wr, int wc, int fr, int fq) const {
        const int b = u.pm >> 4, grp = u.pn >> 2;
        const int row0 = u.pm * 256 + wr * 64 + fr, colt = (u.pn & 3) * 256 + wc * 32 + fq * 8, gcol = u.pn * 256 + wc * 32 + fq * 8;
        f32x4 sw[2][2], lb[2][2];
#pragma unroll
        for (int bj = 0; bj < 2; ++bj)
#pragma unroll
            for (int n = 0; n < 2; ++n) { sw[bj][n] = *(const f32x4*)(SW + (size_t)b * DIN + gcol + bj * 128 + n * 4); lb[bj][n] = (grp == 1) ? *(const f32x4*)(LBl + colt + bj * 128 + n * 4) : (f32x4){0.f, 0.f, 0.f, 0.f}; }
#pragma unroll
        for (int ai = 0; ai < 2; ++ai)
#pragma unroll
            for (int m = 0; m < 4; ++m) {
                const int row = row0 + ai * 128 + m * 16; const float r = RSTD[ui * 256 + ai * 128 + wr * 64 + m * 16 + fr];
#pragma unroll
                for (int bj = 0; bj < 2; ++bj) {
                    f32x4 p0 = acc[ai][bj][m][0] * r + sw[bj][0], p1 = acc[ai][bj][m][1] * r + sw[bj][1];
                    const size_t o = (size_t)row * DH + colt + bj * 128;
                    if (grp == 0) { *(u32x4*)(Q + o) = pack8(silu4(p0) * QSCALE, silu4(p1) * QSCALE); }
                    else if (grp == 1) { f32x4 l0, l1; l0.x = logf_of(p0.x, lb[bj][0].x); l0.y = logf_of(p0.y, lb[bj][0].y); l0.z = logf_of(p0.z, lb[bj][0].z); l0.w = logf_of(p0.w, lb[bj][0].w);
                        l1.x = logf_of(p1.x, lb[bj][1].x); l1.y = logf_of(p1.y, lb[bj][1].y); l1.z = logf_of(p1.z, lb[bj][1].z); l1.w = logf_of(p1.w, lb[bj][1].w);
                        const f32x8_t ff = {l0.x, l0.y, l0.z, l0.w, l1.x, l1.y, l1.z, l1.w}; *(f16x8_t*)(LF + o) = __builtin_convertvector(ff, f16x8_t); }
                    else if (grp == 2) { *(u32x4*)(V + o) = pack8(p0, p1); }
                    else if (grp == 3) { *(u32x4*)(SG + o) = pack8(silu4(p0), silu4(p1)); }
                    else { *(u32x4*)(U + o) = pack8(p0, p1); }
                }
            }
    }
};
struct FoldOrder {
    int G, c;
    __host__ __device__ __forceinline__ void init(int G_, int c_) { G = G_; c = c_; }
    __host__ __device__ __forceinline__ bool next(int i, pg8::Unit& u) const { const long Lx = (long)i * G + c; if (Lx >= 128) return false; const int Lq = (int)Lx; u.pm = 8 * (Lq >> 5) + (Lq & 7); u.pn = (Lq >> 3) & 3; return true; }
    __device__ __forceinline__ size_t b_off(const pg8::Unit& u) const { return (size_t)(u.pm >> 3) * 4 * 131072; }
    __device__ __forceinline__ void a_ready(const pg8::Unit&) const {}
    __device__ __forceinline__ void done(const pg8::Unit&) const {}
};
struct EpiFold {
    static constexpr bool PERM = true;
    bf16_t* WT;
    __device__ __forceinline__ void operator()(f32x4 (&acc)[2][2][4][2], const pg8::Unit& u, int ui, int wr, int wc, int fr, int fq) const {
        const int row0 = u.pm * 256 + wr * 64 + fr, col = DH + u.pn * 256 + wc * 32 + fq * 8;
        float one = 1.f; asm volatile("" : "+v"(one));
#pragma unroll
        for (int ai = 0; ai < 2; ++ai)
#pragma unroll
            for (int m = 0; m < 4; ++m) { const int row = row0 + ai * 128 + m * 16;
#pragma unroll
                for (int bj = 0; bj < 2; ++bj) *(u32x4*)(WT + xs_off(row, col + bj * 128)) = pack8(acc[ai][bj][m][0] * one, acc[ai][bj][m][1] * one); }
    }
};
struct EpiRes {
    static constexpr bool PERM = true;
    const void* xin; void* xout; const float* gate; const float* GS; bf16_t* XS; float* RSS; int in_f32, out_f32;
    template <bool INF32, int M0, int M1> __device__ __forceinline__ void half(f32x4 (&acc)[2][2][4][2], int ai, int b, int row0, int col, int pn, int wc, int fr, int fq) const {
        f32x4 xv[4][2][2];
        if (INF32) {
#pragma unroll
            for (int m = M0; m < M1; ++m)
#pragma unroll
                for (int bj = 0; bj < 2; ++bj) { const float* p = (const float*)xin + (size_t)(row0 + ai * 128 + m * 16) * D + col + bj * 128; xv[m][bj][0] = *(const f32x4*)p; xv[m][bj][1] = *(const f32x4*)(p + 4); }
        } else {
            f16x8_t hh[4][2];
#pragma unroll
            for (int m = M0; m < M1; ++m)
#pragma unroll
                for (int bj = 0; bj < 2; ++bj) hh[m][bj] = *(const f16x8_t*)((const bf16_t*)xin + (size_t)(row0 + ai * 128 + m * 16) * D + col + bj * 128);
#pragma unroll
            for (int m = M0; m < M1; ++m)
#pragma unroll
                for (int bj = 0; bj < 2; ++bj) { const f32x8_t ff = __builtin_convertvector(hh[m][bj], f32x8_t); xv[m][bj][0] = (f32x4){ff[0], ff[1], ff[2], ff[3]}; xv[m][bj][1] = (f32x4){ff[4], ff[5], ff[6], ff[7]}; }
        }
        f32x4 gt[2][2], gs[2][2];
#pragma unroll
        for (int bj = 0; bj < 2; ++bj)
#pragma unroll
            for (int n = 0; n < 2; ++n) { gt[bj][n] = *(const f32x4*)(gate + (size_t)b * 6 * D + col + bj * 128 + n * 4); gs[bj][n] = XS ? *(const f32x4*)(GS + (size_t)b * D + col + bj * 128 + n * 4) : (f32x4){0.f, 0.f, 0.f, 0.f}; }
        __builtin_amdgcn_sched_barrier(0);
#pragma unroll
        for (int m = M0; m < M1; ++m) { const int row = row0 + ai * 128 + m * 16; float ss = 0.f;
#pragma unroll
            for (int bj = 0; bj < 2; ++bj) { const size_t o = (size_t)row * D + col + bj * 128;
                const f32x4 x0 = xv[m][bj][0] + gt[bj][0] * acc[ai][bj][m][0], x1 = xv[m][bj][1] + gt[bj][1] * acc[ai][bj][m][1];
                if (out_f32) { *(f32x4*)((float*)xout + o) = x0; *(f32x4*)((float*)xout + o + 4) = x1; }
                else { const f32x8_t ff = {x0.x, x0.y, x0.z, x0.w, x1.x, x1.y, x1.z, x1.w}; *(f16x8_t*)((bf16_t*)xout + o) = __builtin_convertvector(ff, f16x8_t); }
                ss += ((x0.x * x0.x + x0.y * x0.y) + (x0.z * x0.z + x0.w * x0.w)) + ((x1.x * x1.x + x1.y * x1.y) + (x1.z * x1.z + x1.w * x1.w));
                if (XS) *(u32x4*)(XS + xs_off(row0, col) + (ai * 128 + m * 16) * 64 + bj * (2 * 256 * 64)) = pack8(x0 * gs[bj][0], x1 * gs[bj][1]); }
            { const int ln = fr + 16 * fq; ss += bperm(ss, ln ^ 16); ss += bperm(ss, ln ^ 32); }
            if (fq == 0) RSS[(size_t)row * 32 + pn * 4 + wc] = ss; }
    }
    __device__ __forceinline__ void operator()(f32x4 (&acc)[2][2][4][2], const pg8::Unit& u, int ui, int wr, int wc, int fr, int fq) const {
        const int b = u.pm >> 4, row0 = u.pm * 256 + wr * 64 + fr, col = u.pn * 256 + wc * 32 + fq * 8;
        if (in_f32) {
#pragma unroll
            for (int ai = 0; ai < 2; ++ai) { half<true, 0, 2>(acc, ai, b, row0, col, u.pn, wc, fr, fq); half<true, 2, 4>(acc, ai, b, row0, col, u.pn, wc, fr, fq); } }
        else { half<false, 0, 4>(acc, 0, b, row0, col, u.pn, wc, fr, fq); half<false, 0, 4>(acc, 1, b, row0, col, u.pn, wc, fr, fq); }
    }
};
template <int CTRL> __device__ __forceinline__ float dpp_z(float v) { return __int_as_float(__builtin_amdgcn_update_dpp(0, __float_as_int(v), CTRL, 0xf, 0xf, false)); }
struct EpiUp {
    static constexpr bool PERM = true;
    const LAS float* RSTD; const float* SW; const float* cw; const float* cb; bf16_t* ACT; float* HA; float* HV;
    __device__ __forceinline__ void operator()(f32x4 (&acc)[2][2][4][2], const pg8::Unit& u, int ui, int wr, int wc, int fr, int fq) const {
        const int b = u.pm >> 4, lrow = wr * 128 + fr * 8, jc = u.pn * 128 + wc * 32 + fq * 8, swc = u.pn * 256 + wc * 32 + fq * 8;
        {   f32x4 swa[2], swv[2];
#pragma unroll
            for (int n = 0; n < 2; ++n) { swa[n] = *(const f32x4*)(SW + (size_t)b * NUP + swc + n * 4); swv[n] = *(const f32x4*)(SW + (size_t)b * NUP + swc + 128 + n * 4); }
#pragma unroll
            for (int ai = 0; ai < 2; ++ai)
#pragma unroll
                for (int m = 0; m < 4; ++m) { const float r = RSTD[ui * 256 + lrow + 4 * ai + m];
#pragma unroll
                    for (int n = 0; n < 2; ++n) { acc[ai][0][m][n] = acc[ai][0][m][n] * r + swa[n]; acc[ai][1][m][n] = acc[ai][1][m][n] * r + swv[n]; } }
        }
        {   const int kb = u.pm * 2 + wr;
            if (fr == 0) { float* pa = HA + ((size_t)kb * 4) * DFF + jc; float* pv = HV + ((size_t)kb * 2) * DFF + jc;
                *(f32x4*)pa = acc[0][0][0][0]; *(f32x4*)(pa + 4) = acc[0][0][0][1]; *(f32x4*)(pa + DFF) = acc[0][0][1][0]; *(f32x4*)(pa + DFF + 4) = acc[0][0][1][1];
                *(f32x4*)pv = acc[0][1][0][0]; *(f32x4*)(pv + 4) = acc[0][1][0][1]; *(f32x4*)(pv + DFF) = acc[0][1][1][0]; *(f32x4*)(pv + DFF + 4) = acc[0][1][1][1]; }
            if (fr == 15) { float* pa = HA + ((size_t)kb * 4 + 2) * DFF + jc;
                *(f32x4*)pa = acc[1][0][2][0]; *(f32x4*)(pa + 4) = acc[1][0][2][1]; *(f32x4*)(pa + DFF) = acc[1][0][3][0]; *(f32x4*)(pa + DFF + 4) = acc[1][0][3][1]; } }
#pragma unroll
        for (int n = 0; n < 2; ++n) {
            const f32x4 cbv = *(const f32x4*)(cb + jc + n * 4), w0 = *(const f32x4*)(cw + jc + n * 4), w1 = *(const f32x4*)(cw + DFF + jc + n * 4), w2 = *(const f32x4*)(cw + 2 * DFF + jc + n * 4);
            f32x4 p2, p1;
            { const f32x4 x6 = acc[1][0][2][n], x7 = acc[1][0][3][n];
              p2 = (f32x4){dpp_z<0x111>(x6.x), dpp_z<0x111>(x6.y), dpp_z<0x111>(x6.z), dpp_z<0x111>(x6.w)};
              p1 = (f32x4){dpp_z<0x111>(x7.x), dpp_z<0x111>(x7.y), dpp_z<0x111>(x7.z), dpp_z<0x111>(x7.w)}; }
#pragma unroll
            for (int j = 0; j < 8; ++j) { const f32x4 x = acc[j >> 2][0][j & 3][n];
                const f32x4 cv = cbv + w0 * p2 + w1 * p1 + w2 * x;
                acc[j >> 2][1][j & 3][n] = silu4(cv) * acc[j >> 2][1][j & 3][n];
                p2 = p1; p1 = x; }
        }
#pragma unroll
        for (int j = 0; j < 8; ++j) *(u32x4*)(ACT + (size_t)u.pm * (256 * DFF) + (size_t)(jc >> 6) * (256 * 64) + (lrow + j) * 64 + (jc & 63)) = pack8(acc[j >> 2][1][j & 3][0], acc[j >> 2][1][j & 3][1]);
    }
};

constexpr int NTHR_C = 512;
typedef short s16x4 __attribute__((ext_vector_type(4)));
__device__ __forceinline__ unsigned vl_off(unsigned row, unsigned ch) { return 256u * row + 16u * (ch ^ (((row & 3u) << 2) | ((row >> 2) & 3u))); }
__device__ __forceinline__ s16x4 vl_tr_read(LAS unsigned char* vl, int R, int c, int lane) {
    const unsigned q = ((unsigned)lane & 15u) >> 2, p = (unsigned)lane & 3u;
    return __builtin_amdgcn_ds_read_tr16_b64_v4i16((LAS s16x4*)(vl + vl_off((unsigned)R + q, 2u * (unsigned)c + (p >> 1)) + 8u * (p & 1u)));
}
__device__ __forceinline__ void load_lf(const float* LFc, int w, int fr, int fq, float (&lf)[2][8]) {
    const float* p = LFc + 16 * w + fr;
#pragma unroll
    for (int ks = 0; ks < 2; ++ks)
#pragma unroll
        for (int i = 0; i < 8; ++i) lf[ks][i] = p[(size_t)(32 * ks + 8 * fq + i) * DH];
}
__device__ __forceinline__ void cumsum_from(const float (&lf)[2][8], int fr, int fq, float (&b)[2][8], float& blast) {
#pragma unroll
    for (int ks = 0; ks < 2; ++ks) { b[ks][0] = lf[ks][0];
#pragma unroll
        for (int i = 1; i < 8; ++i) b[ks][i] = b[ks][i - 1] + lf[ks][i]; }
    const float T0 = b[0][7], T1 = b[1][7]; float x0 = T0, x1 = T1, y;
    const int ln = fr + 16 * fq;
    y = bperm(x0, (ln - 16) & 63); if (fq >= 1) x0 += y;
    y = bperm(x0, (ln - 32) & 63); if (fq >= 2) x0 += y;
    y = bperm(x1, (ln - 16) & 63); if (fq >= 1) x1 += y;
    y = bperm(x1, (ln - 32) & 63); if (fq >= 2) x1 += y;
    const float tot0 = bperm(x0, fr + 48), tot1 = bperm(x1, fr + 48);
    const float off0 = x0 - T0, off1 = tot0 + x1 - T1;
#pragma unroll
    for (int i = 0; i < 8; ++i) { b[0][i] += off0; b[1][i] += off1; }
    blast = tot0 + tot1;
}
__device__ __forceinline__ void load_v_regs(const bf16_t* Vc, int tid, u32x4 (&vr)[2]) {
#pragma unroll
    for (int j = 0; j < 2; ++j) { const int c = tid + 512 * j, row = c >> 4, ch = c & 15; vr[j] = *(const u32x4*)(Vc + (size_t)row * DH + ch * 8); }
}
__device__ __forceinline__ void store_v_image(LAS unsigned char* vl, int tid, const u32x4 (&vr)[2]) {
#pragma unroll
    for (int j = 0; j < 2; ++j) { const int c = tid + 512 * j, row = c >> 4, ch = c & 15; *(LAS u32x4*)(vl + vl_off(row, ch)) = vr[j]; }
}
constexpr int H_BM = 0, H_KB = 33792, H_VL = 51200;

__device__ __forceinline__ void unpack8(const u32x4 r, float (&o)[8]) { o[0] = __uint_as_float(r.x << 16); o[1] = __uint_as_float(r.x & 0xffff0000u); o[2] = __uint_as_float(r.y << 16); o[3] = __uint_as_float(r.y & 0xffff0000u);
    o[4] = __uint_as_float(r.z << 16); o[5] = __uint_as_float(r.z & 0xffff0000u); o[6] = __uint_as_float(r.w << 16); o[7] = __uint_as_float(r.w & 0xffff0000u); }
__device__ __forceinline__ bf16x8 pack8f(const float (&v)[8]) { u32x4 pk; pk.x = cvt_pk_bf16_c(v[0], v[1]); pk.y = cvt_pk_bf16_c(v[2], v[3]); pk.z = cvt_pk_bf16_c(v[4], v[5]); pk.w = cvt_pk_bf16_c(v[6], v[7]); return __builtin_bit_cast(bf16x8, pk); }
template <class Ord> __device__ __forceinline__ void hgrn_h1(LAS unsigned char* lds, const _Float16* LF, const bf16_t* V, bf16_t* DS, float* DEC, const Ord& O, int tid) {
    const int w = __builtin_amdgcn_readfirstlane(tid >> 6), lane0 = tid & 63, grp = w >> 2, wl = w & 3;
    LAS unsigned char* gb = lds + grp * 50176;
    LAS float* LS = (LAS float*)gb; LAS unsigned char* vl = gb + 33792;
    f16x8_t lc[4]; u32x4 vr[4];
    int item = O.item(grp);
    if (item >= 0) { const int tg = wl * 64 + lane0; const int bh = item >> 6, n = item & 63; const size_t row0 = (size_t)(bh >> 3) * SEQ + (size_t)n * CH;
        const _Float16* lfc = LF + row0 * DH + (bh & 7) * 128; const bf16_t* vc = V + row0 * DH + (bh & 7) * 128;
#pragma unroll
        for (int j = 0; j < 4; ++j) { const int c = tg + 256 * j; lc[j] = *(const f16x8_t*)(lfc + (size_t)(c >> 4) * DH + (c & 15) * 8); vr[j] = *(const u32x4*)(vc + (size_t)(c >> 4) * DH + (c & 15) * 8); } }
    for (int k = 0; O.item(k) >= 0; k += 2) {
        const int nx = O.item(k + 2 + grp);
        int lane = lane0; asm volatile("" : "+v"(lane));
        const int fr = lane & 15, fq = lane >> 4, tg = wl * 64 + lane;
        if (item >= 0) {
#pragma unroll
            for (int j = 0; j < 4; ++j) { const int c = tg + 256 * j; const f32x8_t ff = __builtin_convertvector(lc[j], f32x8_t); LAS float* d = LS + (c >> 4) * 132 + (c & 15) * 8;
                *(LAS f32x4*)d = (f32x4){ff[0], ff[1], ff[2], ff[3]}; *(LAS f32x4*)(d + 4) = (f32x4){ff[4], ff[5], ff[6], ff[7]};
                *(LAS u32x4*)(vl + vl_off(c >> 4, c & 15)) = vr[j]; }
        }
        asm volatile("s_waitcnt lgkmcnt(0)" ::: "memory"); __syncthreads();
        if (nx >= 0) {
            const int bh = nx >> 6, n = nx & 63; const size_t row0 = (size_t)(bh >> 3) * SEQ + (size_t)n * CH; const _Float16* lfc = LF + row0 * DH + (bh & 7) * 128; const bf16_t* vc = V + row0 * DH + (bh & 7) * 128;
#pragma unroll
            for (int j = 0; j < 4; ++j) { const int c = tg + 256 * j; lc[j] = *(const f16x8_t*)(lfc + (size_t)(c >> 4) * DH + (c & 15) * 8); vr[j] = *(const u32x4*)(vc + (size_t)(c >> 4) * DH + (c & 15) * 8); } }
        if (item >= 0) {
            bf16x8 kf[2][2]; float bl[2];
#pragma unroll
            for (int ps = 0; ps < 2; ++ps) { float lf[2][8], b[2][8]; const int d = 16 * (2 * wl + ps) + fr;
#pragma unroll
                for (int ks = 0; ks < 2; ++ks)
#pragma unroll
                    for (int i = 0; i < 8; ++i) lf[ks][i] = LS[(32 * ks + 8 * fq + i) * 132 + d];
                cumsum_from(lf, fr, fq, b, bl[ps]);
#pragma unroll
                for (int ks = 0; ks < 2; ++ks) { float kv[8];
#pragma unroll
                    for (int i = 0; i < 8; ++i) kv[i] = (1.f - __expf(lf[ks][i])) * __expf(bl[ps] - b[ks][i]);
                    kf[ps][ks] = pack8f(kv); } }
            bf16_t* dsp = DS + (size_t)item * (HD * HD);
#pragma unroll
            for (int c = 0; c < 8; ++c) { f32x4 acc0 = (f32x4){0.f, 0.f, 0.f, 0.f}, acc1 = (f32x4){0.f, 0.f, 0.f, 0.f};
#pragma unroll
                for (int ks = 0; ks < 2; ++ks) { const s16x4 lo = vl_tr_read(vl, 32 * ks + 8 * fq, c, lane), hi = vl_tr_read(vl, 32 * ks + 8 * fq + 4, c, lane);
                    const bf16x8 vf = __builtin_shufflevector(lo, hi, 0, 1, 2, 3, 4, 5, 6, 7);
                    acc0 = __builtin_amdgcn_mfma_f32_16x16x32_bf16(kf[0][ks], vf, acc0, 0, 0, 0);
                    acc1 = __builtin_amdgcn_mfma_f32_16x16x32_bf16(kf[1][ks], vf, acc1, 0, 0, 0); }
                u32x2 o0, o1; o0.x = cvt_pk_bf16_c(acc0.x, acc0.y); o0.y = cvt_pk_bf16_c(acc0.z, acc0.w); o1.x = cvt_pk_bf16_c(acc1.x, acc1.y); o1.y = cvt_pk_bf16_c(acc1.z, acc1.w);
                const auto r0 = __builtin_amdgcn_permlane16_swap(o0.x, o1.x, false, false); const auto r1 = __builtin_amdgcn_permlane16_swap(o0.y, o1.y, false, false);
                u32x4 wv; wv.x = r0[0]; wv.y = r1[0]; wv.z = r0[1]; wv.w = r1[1];
                *(u32x4*)(dsp + (size_t)(16 * c + fr) * HD + 32 * wl + ((fq & 1) ? 16 + 4 * (fq - 1) : 4 * fq)) = wv; }
            if (fq == 0) { DEC[(size_t)item * HD + 32 * wl + fr] = __expf(bl[0]); DEC[(size_t)item * HD + 32 * wl + 16 + fr] = __expf(bl[1]); }
        }
        asm volatile("s_waitcnt lgkmcnt(0)" ::: "memory"); __syncthreads();
        item = nx;
    }
}
__device__ __forceinline__ void acc8(float (&s)[8], const u32x4 r, float sg) {
    s[0] += sg * __uint_as_float(r.x << 16); s[1] += sg * __uint_as_float(r.x & 0xffff0000u); s[2] += sg * __uint_as_float(r.y << 16); s[3] += sg * __uint_as_float(r.y & 0xffff0000u);
    s[4] += sg * __uint_as_float(r.z << 16); s[5] += sg * __uint_as_float(r.z & 0xffff0000u); s[6] += sg * __uint_as_float(r.w << 16); s[7] += sg * __uint_as_float(r.w & 0xffff0000u); }
template <int W> __device__ __forceinline__ void pool_item(const bf16_t* up, bf16_t* pp, int ldo, int t0) {
    u32x4 pv[W], ur[16];
    if (t0 > 0) {
#pragma unroll
        for (int k = 0; k < W; ++k) pv[k] = *(const u32x4*)(up + (ptrdiff_t)(k - W) * DP); }
#pragma unroll
    for (int i = 0; i < 16; ++i) ur[i] = *(const u32x4*)(up + (size_t)i * DP);
    float sum[8];
#pragma unroll
    for (int j = 0; j < 8; ++j) sum[j] = 0.f;
    if (t0 > 0) {
#pragma unroll
        for (int k = 0; k < W; ++k) acc8(sum, pv[k], 1.f); }
#pragma unroll
    for (int i = 0; i < 16; ++i) { float u[8]; unpack8(ur[i], u);
#pragma unroll
        for (int j = 0; j < 8; ++j) sum[j] += u[j];
        if (i >= W) acc8(sum, ur[i >= W ? i - W : 0], -1.f); else if (t0 > 0) acc8(sum, pv[i < W ? i : 0], -1.f);
        const float inv = (t0 > 0 || i + 1 >= W) ? 1.f / (float)W : 1.f / (float)(i + 1);
        u32x4 o; o.x = cvt_pk_bf16_c(sum[0] * inv - u[0], sum[1] * inv - u[1]); o.y = cvt_pk_bf16_c(sum[2] * inv - u[2], sum[3] * inv - u[3]);
        o.z = cvt_pk_bf16_c(sum[4] * inv - u[4], sum[5] * inv - u[5]); o.w = cvt_pk_bf16_c(sum[6] * inv - u[6], sum[7] * inv - u[7]);
        *(u32x4*)(pp + (size_t)i * ldo) = o; }
}
__device__ __forceinline__ void pool_elem(const bf16_t* U, bf16_t* PO, int ldo, int cid, int G, int tid) {
    if (tid < 256) return;
    const int pw = cid * 4 + ((tid - 256) >> 6), lane = tid & 63;
    for (int wi = pw; wi < (M / 32) * 4; wi += G * 4) {
        const int g = __builtin_amdgcn_readfirstlane(wi & 3), rp = wi >> 2, r16 = 2 * rp + (lane >> 5), oct = 32 * g + (lane & 31); const int row0 = 16 * r16, t0 = row0 % SEQ;
        const bf16_t* up = U + (size_t)row0 * DP + oct * 8; bf16_t* pp = PO + xs_off(row0, DH + oct * 8);
        if (g == 0) pool_item<2>(up, pp, ldo, t0); else if (g == 1) pool_item<4>(up, pp, ldo, t0); else if (g == 2) pool_item<8>(up, pp, ldo, t0); else pool_item<16>(up, pp, ldo, t0);
    }
}
__device__ __forceinline__ void hgrn_h2(LAS unsigned char* lds, bf16_t* DS, const float* DEC, int cid, int G, int tid) {
    if (tid < 256) { const int lane = tid & 63; LAS float* DL = (LAS float*)(lds + (tid >> 6) * 32768);
      for (int g = cid * 256 + tid; g < NB * NH * HD * (HD / 8); g += G * 256) {
        const int bh = g >> 11, v = (g >> 4) & 127, d = (g & 15) * 8;
        bf16_t* p = DS + (size_t)bh * NCH * (HD * HD) + (size_t)v * HD + d; const float* dp = DEC + (size_t)bh * NCH * HD;
        float S[8];
#pragma unroll
        for (int j = 0; j < 8; ++j) S[j] = 0.f;
        u32x4 raw[16];
#pragma unroll
        for (int j = 0; j < 16; ++j) raw[j] = *(const u32x4*)(p + (size_t)j * (HD * HD));
        asm volatile("s_waitcnt lgkmcnt(0)" ::: "memory");
#pragma unroll
        for (int h = 0; h < 4; ++h) { f32x4 t[8];
#pragma unroll
            for (int j = 0; j < 8; ++j) t[j] = *(const f32x4*)(dp + 4 * (lane + 64 * (8 * h + j)));
#pragma unroll
            for (int j = 0; j < 8; ++j) *(LAS f32x4*)(DL + 4 * (lane + 64 * (8 * h + j))) = t[j]; }
        asm volatile("s_waitcnt lgkmcnt(0)" ::: "memory");
#pragma unroll 1
        for (int n0 = 0; n0 < NCH; n0 += 16) {
#pragma unroll
            for (int j = 0; j < 16; ++j) { u32x4 o; o.x = cvt_pk_bf16_c(S[0], S[1]); o.y = cvt_pk_bf16_c(S[2], S[3]); o.z = cvt_pk_bf16_c(S[4], S[5]); o.w = cvt_pk_bf16_c(S[6], S[7]);
                float t[8]; unpack8(raw[j], t);
                if (n0 + 16 < NCH) raw[j] = *(const u32x4*)(p + (size_t)(n0 + 16 + j) * (HD * HD));
                *(u32x4*)(p + (size_t)(n0 + j) * (HD * HD)) = o;
                const f32x4 dc0 = *(const LAS f32x4*)(DL + (n0 + j) * HD + d), dc1 = *(const LAS f32x4*)(DL + (n0 + j) * HD + d + 4);
                S[0] = dc0.x * S[0] + t[0]; S[1] = dc0.y * S[1] + t[1]; S[2] = dc0.z * S[2] + t[2]; S[3] = dc0.w * S[3] + t[3];
                S[4] = dc1.x * S[4] + t[4]; S[5] = dc1.y * S[5] + t[5]; S[6] = dc1.z * S[6] + t[6]; S[7] = dc1.w * S[7] + t[7]; } }
      } }
}

constexpr int H3_ITEM_LDS = 67584;
__device__ __forceinline__ int h3_item(int cid, int G, int grp, int p) {
    if (G == 256) { if (p >= 4) return NB * NH * NCH; const int x = cid & 7, q = (cid >> 3) + 32 * (2 * p + grp); return ((((x >> 1) * 8 + (q & 7)) << 6) + 32 * (x & 1) + (q >> 3)); }
    return cid + grp * G + 2 * G * p;
}
__device__ __forceinline__ void hgrn_h3(LAS unsigned char* lds, const bf16_t* Q, const _Float16* LF, const bf16_t* V, const bf16_t* SG, const bf16_t* SP, const float* gn, bf16_t* YAB, int cid, int G, int tid) {
    const int w = __builtin_amdgcn_readfirstlane(tid >> 6), lane0 = tid & 63, grp = w >> 2, wl = w & 3, tt = grp ? 3 - wl : wl;
    LAS unsigned char* gb = lds + grp * H3_ITEM_LDS;
    LAS float* BM = (LAS float*)(gb + H_BM); LAS unsigned char* KB = gb + H_KB; LAS unsigned char* vl = gb + H_VL;
    f16x8_t lc[4]; u32x4 vr[4];
    int item = h3_item(cid, G, grp, 0);
    if (item < NB * NH * NCH) { const int tg = wl * 64 + lane0; const int bh = item >> 6, n = item & 63; const size_t row0 = (size_t)(bh >> 3) * SEQ + (size_t)n * CH; const _Float16* lfc = LF + row0 * DH + (bh & 7) * 128; const bf16_t* vc = V + row0 * DH + (bh & 7) * 128;
#pragma unroll
        for (int j = 0; j < 4; ++j) { const int c = tg + 256 * j; lc[j] = *(const f16x8_t*)(lfc + (size_t)(c >> 4) * DH + (c & 15) * 8); vr[j] = *(const u32x4*)(vc + (size_t)(c >> 4) * DH + (c & 15) * 8); } }
    for (int p = 0; h3_item(cid, G, 0, p) < NB * NH * NCH; ++p, item = h3_item(cid, G, grp, p)) {
        const bool act = item < NB * NH * NCH;
        int lane = lane0; asm volatile("" : "+v"(lane));
        const int fr = lane & 15, fq = lane >> 4, tg = wl * 64 + lane;
        const int bh = item >> 6, n = item & 63, b_ = bh >> 3, h = bh & 7; const size_t row0 = (size_t)b_ * SEQ + (size_t)n * CH;
        const size_t grow = row0 + 16 * tt + fr;
        const bf16_t* spp = SP + (size_t)item * (HD * HD);
        bf16x8 sf[3][8]; u32x4 qr[4];
        if (act) {
#pragma unroll
            for (int kd = 0; kd < 2; ++kd)
#pragma unroll
                for (int vt = 0; vt < 8; ++vt) sf[kd][vt] = *(const bf16x8*)(spp + (size_t)(16 * vt + fr) * HD + 32 * kd + 8 * fq);
#pragma unroll
            for (int kd = 0; kd < 4; ++kd) qr[kd] = *(const u32x4*)(Q + grow * DH + h * 128 + 32 * kd + 8 * fq);
        }
        if (act) {
#pragma unroll
            for (int j = 0; j < 4; ++j) { const int c = tg + 256 * j; const f32x8_t ff = __builtin_convertvector(lc[j], f32x8_t); LAS float* d = BM + (c >> 4) * 132 + (c & 15) * 8;
                *(LAS f32x4*)d = (f32x4){ff[0], ff[1], ff[2], ff[3]}; *(LAS f32x4*)(d + 4) = (f32x4){ff[4], ff[5], ff[6], ff[7]};
                *(LAS u32x4*)(vl + vl_off(c >> 4, c & 15)) = vr[j]; }
        }
        asm volatile("s_waitcnt lgkmcnt(0)" ::: "memory"); __syncthreads();
        if (act) {
#pragma unroll
            for (int ps = 0; ps < 2; ++ps) { float lf[2][8], b[2][8], blast; const int d = 16 * (2 * wl + ps) + fr; unsigned kpk[2][8];
#pragma unroll
                for (int ks = 0; ks < 2; ++ks)
#pragma unroll
                    for (int i = 0; i < 8; ++i) lf[ks][i] = BM[(32 * ks + 8 * fq + i) * 132 + d];
                cumsum_from(lf, fr, fq, b, blast);
#pragma unroll
                for (int ks = 0; ks < 2; ++ks) { const float rend = bperm(b[ks][7], fr + 16 * (fq | 1));
#pragma unroll
                    for (int i = 0; i < 8; ++i) { const int s_ = 32 * ks + 8 * fq + i; BM[s_ * 132 + d] = b[ks][i];
                        const float kv = (1.f - __expf(lf[ks][i])) * __expf(rend - b[ks][i]);
                        const float ko = __int_as_float(__builtin_amdgcn_update_dpp(0, __float_as_int(kv), 0xB1, 0xf, 0xf, true));
                        kpk[ks][i] = cvt_pk_bf16_c(kv, ko); } }
                if ((fr & 1) == 0) {
#pragma unroll
                    for (int ks = 0; ks < 2; ++ks)
#pragma unroll
                        for (int i = 0; i < 8; ++i) *(LAS unsigned*)(KB + ((32 * ks + 8 * fq + i) * 136 + d) * 2) = kpk[ks][i]; } }
        }
        asm volatile("s_waitcnt lgkmcnt(0)" ::: "memory"); __syncthreads();
        {   const int nx = h3_item(cid, G, grp, p + 1);
            if (nx < NB * NH * NCH) { const int bh2 = nx >> 6, n2 = nx & 63; const size_t r2 = (size_t)(bh2 >> 3) * SEQ + (size_t)n2 * CH; const _Float16* lfc = LF + r2 * DH + (bh2 & 7) * 128; const bf16_t* vc = V + r2 * DH + (bh2 & 7) * 128;
#pragma unroll
                for (int j = 0; j < 4; ++j) { const int c = tg + 256 * j; lc[j] = *(const f16x8_t*)(lfc + (size_t)(c >> 4) * DH + (c & 15) * 8); }
                (void)vc; } }
        if (act) {
            f32x4 acc[8], pt[4];
#pragma unroll
            for (int vt = 0; vt < 8; ++vt) sf[2][vt] = *(const bf16x8*)(spp + (size_t)(16 * vt + fr) * HD + 32 * 2 + 8 * fq);
            const int vsw = (fq & 1) ? 16 + 4 * (fq - 1) : 4 * fq;
            u32x4 sgw[4];
#pragma unroll
            for (int vt = 0; vt < 8; ++vt) acc[vt] = (f32x4){0.f, 0.f, 0.f, 0.f};
#pragma unroll
            for (int st = 0; st < 4; ++st) pt[st] = (f32x4){0.f, 0.f, 0.f, 0.f};
#pragma unroll
            for (int kd = 0; kd < 4; ++kd) {
                float q8[8], bt[8]; unpack8(qr[kd], q8);
                { const f32x4 b0 = *(const LAS f32x4*)(BM + (16 * tt + fr) * 132 + 32 * kd + 8 * fq), b1 = *(const LAS f32x4*)(BM + (16 * tt + fr) * 132 + 32 * kd + 8 * fq + 4);
                  bt[0] = b0.x; bt[1] = b0.y; bt[2] = b0.z; bt[3] = b0.w; bt[4] = b1.x; bt[5] = b1.y; bt[6] = b1.z; bt[7] = b1.w; }
#pragma unroll
                for (int st = 0; st < 4; ++st) if (st <= tt) {
                    const f32x4 r0 = *(const LAS f32x4*)(BM + (16 * st + 15) * 132 + 32 * kd + 8 * fq), r1 = *(const LAS f32x4*)(BM + (16 * st + 15) * 132 + 32 * kd + 8 * fq + 4);
                    float e[8]; e[0] = q8[0] * __expf(bt[0] - r0.x); e[1] = q8[1] * __expf(bt[1] - r0.y); e[2] = q8[2] * __expf(bt[2] - r0.z); e[3] = q8[3] * __expf(bt[3] - r0.w);
                    e[4] = q8[4] * __expf(bt[4] - r1.x); e[5] = q8[5] * __expf(bt[5] - r1.y); e[6] = q8[6] * __expf(bt[6] - r1.z); e[7] = q8[7] * __expf(bt[7] - r1.w);
                    const bf16x8 qf = pack8f(e);
                    const bf16x8 kf = *(const LAS bf16x8*)(KB + ((16 * st + fr) * 136 + 32 * kd + 8 * fq) * 2);
                    pt[st] = __builtin_amdgcn_mfma_f32_16x16x32_bf16(kf, qf, pt[st], 0, 0, 0); }
                { float e[8];
#pragma unroll
                  for (int j = 0; j < 8; ++j) e[j] = q8[j] * __expf(bt[j]);
                  const bf16x8 qb = pack8f(e);
#pragma unroll
                  for (int vt = 0; vt < 8; ++vt) acc[vt] = __builtin_amdgcn_mfma_f32_16x16x32_bf16(sf[kd % 3][vt], qb, acc[vt], 0, 0, 0); }
                if (kd == 0) {
#pragma unroll
                    for (int vt = 0; vt < 8; ++vt) sf[0][vt] = *(const bf16x8*)(spp + (size_t)(16 * vt + fr) * HD + 32 * 3 + 8 * fq); }
                if (kd == 2) {
#pragma unroll
                    for (int j = 0; j < 4; ++j) sgw[j] = *(const u32x4*)(SG + grow * DH + h * 128 + 32 * j + vsw); }
            }
            {   const int nx = h3_item(cid, G, grp, p + 1);
                if (nx < NB * NH * NCH) { const int bh2 = nx >> 6, n2 = nx & 63; const size_t r2 = (size_t)(bh2 >> 3) * SEQ + (size_t)n2 * CH; const bf16_t* vc = V + r2 * DH + (bh2 & 7) * 128;
#pragma unroll
                    for (int j = 0; j < 4; ++j) { const int c = tg + 256 * j; vr[j] = *(const u32x4*)(vc + (size_t)(c >> 4) * DH + (c & 15) * 8); } } }
            u32x2 ppk[4];
#pragma unroll
            for (int st = 0; st < 4; ++st) { f32x4 p = pt[st]; const int sl = 16 * st + 4 * fq, tl = 16 * tt + fr;
                if (sl + 0 > tl) p.x = 0.f; if (sl + 1 > tl) p.y = 0.f; if (sl + 2 > tl) p.z = 0.f; if (sl + 3 > tl) p.w = 0.f;
                ppk[st].x = cvt_pk_bf16_c(p.x, p.y); ppk[st].y = cvt_pk_bf16_c(p.z, p.w); }
#pragma unroll
            for (int kp = 0; kp < 2; ++kp) if (2 * kp <= tt) { u32x4 pw; pw.x = ppk[2 * kp].x; pw.y = ppk[2 * kp].y; pw.z = ppk[2 * kp + 1].x; pw.w = ppk[2 * kp + 1].y; const bf16x8 pf = __builtin_bit_cast(bf16x8, pw);
#pragma unroll
                for (int vt = 0; vt < 8; ++vt) { const s16x4 lo = vl_tr_read(vl, 32 * kp + 4 * fq, vt, lane), hi = vl_tr_read(vl, 32 * kp + 16 + 4 * fq, vt, lane);
                    const bf16x8 vf = __builtin_shufflevector(lo, hi, 0, 1, 2, 3, 4, 5, 6, 7);
                    acc[vt] = __builtin_amdgcn_mfma_f32_16x16x32_bf16(vf, pf, acc[vt], 0, 0, 0); } }
            float ss = 0.f;
#pragma unroll
            for (int vt = 0; vt < 8; ++vt) ss += (acc[vt].x * acc[vt].x + acc[vt].y * acc[vt].y) + (acc[vt].z * acc[vt].z + acc[vt].w * acc[vt].w);
            ss += bperm(ss, lane ^ 16); ss += bperm(ss, lane ^ 32);
            const float rstd = rsqrtf(ss * (1.f / 128.f) + EPS);
#pragma unroll
            for (int j = 0; j < 4; ++j) {
                const auto g0 = __builtin_amdgcn_permlane16_swap(sgw[j].x, sgw[j].z, false, false); const auto g1 = __builtin_amdgcn_permlane16_swap(sgw[j].y, sgw[j].w, false, false);
                u32x2 sg2[2]; sg2[0].x = g0[0]; sg2[0].y = g1[0]; sg2[1].x = g0[1]; sg2[1].y = g1[1];
                u32x2 o2[2];
#pragma unroll
                for (int q = 0; q < 2; ++q) { const int vt = 2 * j + q, vc = 16 * vt + 4 * fq; const f32x4 g4 = *(const f32x4*)(gn + vc);
                    const float s0 = __uint_as_float(sg2[q].x << 16), s1 = __uint_as_float(sg2[q].x & 0xffff0000u), s2 = __uint_as_float(sg2[q].y << 16), s3 = __uint_as_float(sg2[q].y & 0xffff0000u);
                    o2[q].x = cvt_pk_bf16_c(acc[vt].x * rstd * g4.x * s0, acc[vt].y * rstd * g4.y * s1); o2[q].y = cvt_pk_bf16_c(acc[vt].z * rstd * g4.z * s2, acc[vt].w * rstd * g4.w * s3); }
                const auto r0 = __builtin_amdgcn_permlane16_swap(o2[0].x, o2[1].x, false, false); const auto r1 = __builtin_amdgcn_permlane16_swap(o2[0].y, o2[1].y, false, false);
                u32x4 wv; wv.x = r0[0]; wv.y = r1[0]; wv.z = r0[1]; wv.w = r1[1];
                *(u32x4*)(YAB + xs_off((int)grow, h * 128 + 32 * j + vsw)) = wv; }
        }
        asm volatile("s_waitcnt lgkmcnt(0)" ::: "memory"); __syncthreads();
    }
}

__device__ __forceinline__ void wt_item(const float* W, int K, int N, bf16_t* WT, bool upmap, LAS float* scr, int item, int lane) {
    const int nblk = N / 32, kb = item / nblk, nb = item % nblk, k0 = 64 * kb, n0 = 32 * nb;
    {   f32x4 t[8];
#pragma unroll
        for (int i = 0; i < 8; ++i) t[i] = *(const f32x4*)(W + (size_t)(k0 + (lane >> 3) + 8 * i) * N + n0 + 4 * (lane & 7));
#pragma unroll
        for (int i = 0; i < 8; ++i) { LAS float* d = scr + ((lane >> 3) + 8 * i) * 33 + 4 * (lane & 7); d[0] = t[i].x; d[1] = t[i].y; d[2] = t[i].z; d[3] = t[i].w; } }
    asm volatile("s_waitcnt lgkmcnt(0)" ::: "memory");
    const int c = lane & 7, r0 = upmap ? up_rowmap(n0) : n0;
#pragma unroll
    for (int j = 0; j < 4; ++j) { const int n = (lane >> 3) + 8 * j; const LAS float* sp = scr + (8 * c) * 33 + n;
        u32x4 o; o.x = cvt_pk_bf16_c(sp[0 * 33], sp[1 * 33]); o.y = cvt_pk_bf16_c(sp[2 * 33], sp[3 * 33]); o.z = cvt_pk_bf16_c(sp[4 * 33], sp[5 * 33]); o.w = cvt_pk_bf16_c(sp[6 * 33], sp[7 * 33]);
        *(u32x4*)(WT + (size_t)(r0 + n) * K + k0 + 8 * c) = o; }
    asm volatile("s_waitcnt lgkmcnt(0)" ::: "memory");
}
template <bool WITH_SW, bool TILED = false> __device__ __forceinline__ void wt_col_item(const float* W, int N, bf16_t* WT, int Kst, int kb0, int kb1, bool upmap, LAS float* scr, int nb, int lane, const float* shift, float* SWo) {
    const int n0 = 32 * nb, c = lane & 7, r0 = upmap ? up_rowmap(n0) : n0;
    f32x4 t[8];
#pragma unroll
    for (int i = 0; i < 8; ++i) t[i] = *(const f32x4*)(W + (size_t)(64 * kb0 + (lane >> 3) + 8 * i) * N + n0 + 4 * (lane & 7));
    float a[4][NB];
#pragma unroll
    for (int j = 0; j < 4; ++j)
#pragma unroll
        for (int b = 0; b < NB; ++b) a[j][b] = 0.f;
    for (int kb = kb0; kb < kb1; ++kb) { const int k0 = 64 * kb;
#pragma unroll
        for (int i = 0; i < 8; ++i) { LAS float* d = scr + ((lane >> 3) + 8 * i) * 33 + 4 * (lane & 7); d[0] = t[i].x; d[1] = t[i].y; d[2] = t[i].z; d[3] = t[i].w; }
        if (kb + 1 < kb1) {
#pragma unroll
            for (int i = 0; i < 8; ++i) t[i] = *(const f32x4*)(W + (size_t)(k0 + 64 + (lane >> 3) + 8 * i) * N + n0 + 4 * (lane & 7)); }
        f32x4 s0[NB], s1[NB];
        if constexpr (WITH_SW) {
#pragma unroll
            for (int b = 0; b < NB; ++b) { s0[b] = *(const f32x4*)(shift + (size_t)b * 6 * D + k0 + 8 * c); s1[b] = *(const f32x4*)(shift + (size_t)b * 6 * D + k0 + 8 * c + 4); } }
        asm volatile("s_waitcnt lgkmcnt(0)" ::: "memory");
#pragma unroll
        for (int j = 0; j < 4; ++j) { const int n = (lane >> 3) + 8 * j; const LAS float* sp = scr + (8 * c) * 33 + n;
            u32x4 o; o.x = cvt_pk_bf16_c(sp[0 * 33], sp[1 * 33]); o.y = cvt_pk_bf16_c(sp[2 * 33], sp[3 * 33]); o.z = cvt_pk_bf16_c(sp[4 * 33], sp[5 * 33]); o.w = cvt_pk_bf16_c(sp[6 * 33], sp[7 * 33]);
            if constexpr (TILED) *(u32x4*)(WT + (size_t)((r0 + n) >> 8) * ((size_t)256 * Kst) + (size_t)(k0 >> 6) * (256 * 64) + ((r0 + n) & 255) * 64 + 8 * c) = o;
            else *(u32x4*)(WT + (size_t)(r0 + n) * Kst + k0 + 8 * c) = o;
            if constexpr (WITH_SW) { float wv[8]; unpack8(o, wv);
#pragma unroll
                for (int b = 0; b < NB; ++b) a[j][b] += (s0[b].x * wv[0] + s0[b].y * wv[1]) + (s0[b].z * wv[2] + s0[b].w * wv[3]) + (s1[b].x * wv[4] + s1[b].y * wv[5]) + (s1[b].z * wv[6] + s1[b].w * wv[7]); } }
        asm volatile("s_waitcnt lgkmcnt(0)" ::: "memory");
    }
    if constexpr (WITH_SW) {
#pragma unroll
        for (int j = 0; j < 4; ++j)
#pragma unroll
            for (int b = 0; b < NB; ++b) { float v = a[j][b]; v += bperm(v, lane ^ 1); v += bperm(v, lane ^ 2); v += bperm(v, lane ^ 4);
                if (c == 0) SWo[(size_t)b * N + r0 + (lane >> 3) + 8 * j] = v; } }
}
constexpr int WT_I_IN = (D / 64) * (DIN / 32), WT_I_OUT = (D / 64) * (D / 32), WT_I_UP = (D / 64) * (NUP / 32), WT_I_DN = (DFF / 64) * (D / 32), WT_I_PL = (256 / 64) * (256 / 32);
constexpr int WT_ITEMS = L * (WT_I_OUT + WT_I_DN);
constexpr int MOD_KC = 32;
__device__ __forceinline__ void pro_a(LAS unsigned char* lds, const float* const* in, unsigned char* wsl, int cid, int G, int tid) {
    const int wave = __builtin_amdgcn_readfirstlane(tid >> 6), lane = tid & 63;
    {   LAS float* ca = (LAS float*)lds;
        for (int item = cid; item < L * MOD_KC * 2; item += G) {
            const int l = item / (MOD_KC * 2), kc = (item / 2) % MOD_KC, nh = item & 1;
            __syncthreads();
            if (tid < 256) { const int k = tid >> 2, b = tid & 3; ca[tid] = siluf(in[1][(size_t)b * D + kc * 64 + k]); }
            __syncthreads();
            const float* w = in[2] + ((size_t)l * D + (size_t)kc * 64) * (6 * D) + nh * (3 * D);
            f32x4 acc[3][4];
#pragma unroll
            for (int j = 0; j < 3; ++j)
#pragma unroll
                for (int b = 0; b < 4; ++b) acc[j][b] = (f32x4){0.f, 0.f, 0.f, 0.f};
#pragma unroll 8
            for (int k = 0; k < 64; ++k) { const f32x4 cb = *(const LAS f32x4*)(ca + 4 * k);
#pragma unroll
                for (int j = 0; j < 3; ++j) { const f32x4 wv = *(const f32x4*)(w + (size_t)k * (6 * D) + 4 * (tid + 512 * j));
                    acc[j][0] += wv * cb.x; acc[j][1] += wv * cb.y; acc[j][2] += wv * cb.z; acc[j][3] += wv * cb.w; } }
            float* mp = (float*)(wsl + O_MODP) + ((size_t)kc * L + l) * NB * (6 * D) + nh * (3 * D);
#pragma unroll
            for (int j = 0; j < 3; ++j)
#pragma unroll
                for (int b = 0; b < 4; ++b) *(f32x4*)(mp + (size_t)b * (6 * D) + 4 * (tid + 512 * j)) = acc[j][b];
        }
        __syncthreads();
    }
    for (int c = cid * NTHR_C + tid; c < DH; c += G * NTHR_C) {
        float v[L], mx = -1e30f;
#pragma unroll
        for (int l = 0; l < L; ++l) { v[l] = in[6][l * DH + c]; mx = fmaxf(mx, v[l]); }
        float s_ = 0.f;
#pragma unroll
        for (int l = 0; l < L; ++l) { v[l] = __expf(v[l] - mx); s_ += v[l]; }
        const float p0 = v[0] / s_; float cum = 0.f;
#pragma unroll
        for (int l = 0; l < L; ++l) { cum += v[l] / s_; ((float*)(wsl + O_LB))[l * DH + c] = fminf(fmaxf(cum - p0, 0.f), 1.f); }
    }
    {   LAS float* scr = (LAS float*)(lds + wave * 16384);
        constexpr int SEG = 8, I_OUT = (D / 64 / SEG) * (D / 32), I_DN = (DFF / 64 / SEG) * (D / 32);
        static_assert((D / 64) % SEG == 0 && (DFF / 64) % SEG == 0, "segments");
        for (int it = cid * 8 + wave; it < L * (I_OUT + I_DN); it += G * 8) { const int l = it / (I_OUT + I_DN), r = it % (I_OUT + I_DN);
            if (r < I_OUT) { const int sg = r / (D / 32), nb = r % (D / 32); wt_col_item<false, true>(in[10] + (size_t)l * D * D, D, (bf16_t*)(wsl + O_WTOUT) + (size_t)l * D * D, D, sg * SEG, sg * SEG + SEG, false, scr, nb, lane, nullptr, nullptr); }
            else { const int r2 = r - I_OUT, sg = r2 / (D / 32), nb = r2 % (D / 32); wt_col_item<false, true>(in[15] + (size_t)l * DFF * D, D, (bf16_t*)(wsl + O_WTDN) + (size_t)l * D * DFF, DFF, sg * SEG, sg * SEG + SEG, false, scr, nb, lane, nullptr, nullptr); } } }
    for (int i = cid * NTHR_C + tid; i < L * 4 * 256 * 256 / 8; i += G * NTHR_C) { const int e0 = (i & 31) * 8, lg = i >> 13;
        const f32x4 a0 = *(const f32x4*)(in[8] + (size_t)i * 8), a1 = *(const f32x4*)(in[8] + (size_t)i * 8 + 4);
        const f32x4 s0 = *(const f32x4*)(in[9] + lg * 256 + e0), s1 = *(const f32x4*)(in[9] + lg * 256 + e0 + 4);
        u32x4 o; o.x = cvt_pk_bf16_c(a0.x * s0.x, a0.y * s0.y); o.y = cvt_pk_bf16_c(a0.z * s0.z, a0.w * s0.w); o.z = cvt_pk_bf16_c(a1.x * s1.x, a1.y * s1.y); o.w = cvt_pk_bf16_c(a1.z * s1.z, a1.w * s1.w);
        *(u32x4*)((bf16_t*)(wsl + O_WTPL) + (size_t)i * 8) = o; }
}
__device__ __forceinline__ void pro_b(const float* const* in, unsigned char* wsl, int cid, int G, int tid) {
    const float* mp = (const float*)(wsl + O_MODP); float* MOD = (float*)(wsl + O_MOD);
    for (int i = cid * NTHR_C + tid; i < L * NB * 6 * D; i += G * NTHR_C) {
        const int l = i / (NB * 6 * D), n = i % (6 * D); float a = in[3][l * 6 * D + n];
#pragma unroll 8
        for (int kc = 0; kc < MOD_KC; ++kc) a += mp[(size_t)kc * (L * NB * 6 * D) + i];
        MOD[i] = a; }
}
__device__ __forceinline__ void pro_c(LAS unsigned char* lds, const float* const* in, unsigned char* wsl, int cid, int G, int tid) {
    const int wave = __builtin_amdgcn_readfirstlane(tid >> 6), lane = tid & 63;
    const float* MOD = (const float*)(wsl + O_MOD);
    for (int i = cid * NTHR_C + tid; i < L * NB * D; i += G * NTHR_C) { const int k = i % D, lb = i / D, l = lb / NB;
        ((float*)(wsl + O_GS1))[i] = in[4][l * D + k] * (1.f + MOD[(size_t)lb * 6 * D + D + k]);
        ((float*)(wsl + O_GS2))[i] = in[11][l * D + k] * (1.f + MOD[(size_t)lb * 6 * D + 4 * D + k]); }
    {   LAS float* scr = (LAS float*)(lds + wave * 16384); constexpr int CI = DIN / 32 + NUP / 32;
        for (int it = cid * 8 + wave; it < L * CI; it += G * 8) { const int l = it / CI, r = it % CI;
            if (r < DIN / 32) wt_col_item<true, true>(in[5] + (size_t)l * D * DIN, DIN, (bf16_t*)(wsl + O_WTIN) + (size_t)l * DIN * D, D, 0, D / 64, false, scr, r, lane, MOD + (size_t)l * NB * 6 * D, (float*)(wsl + O_SW1) + (size_t)l * NB * DIN);
            else wt_col_item<true, true>(in[12] + (size_t)l * D * NUP, NUP, (bf16_t*)(wsl + O_WTUP) + (size_t)l * NUP * D, D, 0, D / 64, true, scr, r - DIN / 32, lane, MOD + (size_t)l * NB * 6 * D + 3 * D, (float*)(wsl + O_SW2) + (size_t)l * NB * NUP); } }
    for (int row = cid * 8 + wave; row < M; row += G * 8) { const int b = row / SEQ;
        const float* xr = in[0] + (size_t)row * D; bf16_t* xs = (bf16_t*)(wsl + O_XS); float* rss = (float*)(wsl + O_RSS1) + (size_t)row * 32;
#pragma unroll
        for (int j = 0; j < 8; ++j) { const int c = 4 * lane + 256 * j; const f32x4 v = *(const f32x4*)(xr + c);
            const f32x4 g = *(const f32x4*)(in[4] + c), sc = *(const f32x4*)(MOD + (size_t)b * 6 * D + D + c);
            u32x2 o; o.x = cvt_pk_bf16_c(v.x * (g.x * (1.f + sc.x)), v.y * (g.y * (1.f + sc.y))); o.y = cvt_pk_bf16_c(v.z * (g.z * (1.f + sc.z)), v.w * (g.w * (1.f + sc.w)));
            *(u32x2*)(xs + xs_off(row, c)) = o;
            float ss = (v.x * v.x + v.y * v.y) + (v.z * v.z + v.w * v.w);
            ss += bperm(ss, lane ^ 1); ss += bperm(ss, lane ^ 2); ss += bperm(ss, lane ^ 4); ss += bperm(ss, lane ^ 8);
            if ((lane & 15) == 0) rss[4 * j + (lane >> 4)] = ss; }
    }
}

#define XB_TMO      128
#define XB_XCNT(j)  (256  + 64 * (j))
#define XB_XSUB(j)  (1280 + 64 * (j))
#define XB_XGEN(j)  (2304 + 64 * (j))
#define XB_TOP      3328
#define XB_TOPGEN   3392
#define XCD_BAR_WORDS 3456
#define XB_SPIN_CAP (1u << 18)
__device__ __forceinline__ unsigned xb_ld(unsigned* p)              { return __hip_atomic_load(p, __ATOMIC_RELAXED, __HIP_MEMORY_SCOPE_AGENT); }
__device__ __forceinline__ unsigned xb_add(unsigned* p, unsigned v) { return __hip_atomic_fetch_add(p, v, __ATOMIC_RELAXED, __HIP_MEMORY_SCOPE_AGENT); }
__device__ __forceinline__ unsigned xb_xcc_id() { return (unsigned)__builtin_amdgcn_s_getreg((3 << 11) | 20) & 0xFu; }
#define XB_SPIN(cond, bar) do { unsigned _sp = 0; while (cond) { __builtin_amdgcn_s_sleep(1); \
    if ((++_sp & 255u) == 0u) { if (xb_ld(&(bar)[XB_TMO])) break; if (_sp > XB_SPIN_CAP) { atomicAdd(&(bar)[XB_TMO], 1u); break; } } } } while (0)
struct XcdBarrier { unsigned* bar; unsigned x; volatile LAS unsigned* st; bool t0; };
__device__ __forceinline__ XcdBarrier xcd_barrier_post(unsigned* bar, volatile LAS unsigned* st, bool t0) {
    XcdBarrier b; b.bar = bar; b.x = xb_xcc_id(); b.st = st; b.t0 = t0;
    if (b.t0) (void)xb_add(&bar[XB_XCNT(b.x)], 1u);
    return b;
}
__device__ __forceinline__ void xcd_barrier_complete(unsigned* bar, unsigned x, unsigned& nloc, unsigned& nx) {
    const unsigned G = gridDim.x * gridDim.y * gridDim.z;
    unsigned sum, cnt, mine, sp = 0u;
    for (;;) {
        sum = 0u; cnt = 0u; mine = 0u;
#pragma unroll
        for (unsigned j = 0; j < 16; ++j) { const unsigned c = xb_ld(&bar[XB_XCNT(j)]); sum += c; cnt += (c > 0u) ? 1u : 0u; mine = (j == x) ? c : mine; }
        if (sum == G) break;
        __builtin_amdgcn_s_sleep(1);
        if ((++sp & 255u) == 0u) { if (xb_ld(&bar[XB_TMO])) break; if (sp > XB_SPIN_CAP) { atomicAdd(&bar[XB_TMO], 1u); break; } }
    }
    nloc = mine > 0u ? mine : 1u; nx = cnt > 0u ? cnt : 1u;
}
__device__ __forceinline__ void xcd_barrier(const XcdBarrier& b) {
    asm volatile("s_waitcnt vmcnt(0)" ::: "memory");
    __syncthreads();
    if (b.t0) {
        unsigned* bar = b.bar;
        __builtin_amdgcn_s_waitcnt(0);
        unsigned nloc = b.st[0], nx = b.st[1];
        if (nloc == 0u) { xcd_barrier_complete(bar, b.x, nloc, nx); b.st[0] = nloc; b.st[1] = nx; }
        const unsigned old = xb_add(&bar[XB_XSUB(b.x)], 1u);
        const unsigned gen = old / nloc;
        if (old + 1u == (gen + 1u) * nloc) {
            __builtin_amdgcn_fence(__ATOMIC_RELEASE, "agent");
            asm volatile("s_waitcnt vmcnt(0)" ::: "memory");
            const unsigned og = xb_add(&bar[XB_TOP], 1u);
            const unsigned tg = og / nx;
            if (og + 1u == (tg + 1u) * nx) xb_add(&bar[XB_TOPGEN], 1u);
            else XB_SPIN(xb_ld(&bar[XB_TOPGEN]) == tg, bar);
            __builtin_amdgcn_fence(__ATOMIC_ACQUIRE, "agent");
            xb_add(&bar[XB_XGEN(b.x)], 1u);
            asm volatile("s_waitcnt vmcnt(0)" ::: "memory");
        } else {
            XB_SPIN(xb_ld(&bar[XB_XGEN(b.x)]) == gen, bar);
            __builtin_amdgcn_fence(__ATOMIC_ACQUIRE, "agent");
            asm volatile("s_waitcnt vmcnt(0)" ::: "memory");
        }
    }
    __syncthreads();
}

__device__ __forceinline__ void group_barrier(unsigned* ctl, int cid, int G, bool t0, volatile LAS unsigned* misc) {
    asm volatile("s_waitcnt vmcnt(0)" ::: "memory");
    __syncthreads();
    if (t0) {
        unsigned* cnt = ctl + 8192 + 64 * (cid & 7); unsigned* xid = ctl + 8192 + 1024; unsigned* tmo = ctl + 4096 + XB_TMO;
        unsigned st = misc[0];
        if (st == 0u) { const unsigned mine = xb_ld(&xid[cid]); bool same = true; for (int j = (cid & 7); j < G; j += 8) same = same && (xb_ld(&xid[j]) == mine); st = same ? 1u : 2u; misc[0] = st; }
        if (st != 1u) { __builtin_amdgcn_fence(__ATOMIC_RELEASE, "agent"); asm volatile("s_waitcnt vmcnt(0)" ::: "memory"); }
        const unsigned n = (unsigned)((G - (cid & 7) + 7) / 8);
        const unsigned old = xb_add(cnt, 1u), target = (old / n + 1u) * n; unsigned sp = 0u;
        while (xb_ld(cnt) < target) { __builtin_amdgcn_s_sleep(1); if ((++sp & 255u) == 0u) { if (xb_ld(tmo)) break; if (sp > XB_SPIN_CAP) { atomicAdd(tmo, 1u); break; } } }
        __builtin_amdgcn_fence(__ATOMIC_ACQUIRE, "agent");
        asm volatile("s_waitcnt vmcnt(0)" ::: "memory");
    }
    __syncthreads();
}

constexpr int NWAVES = 8, NTHR = NWAVES * 64;
constexpr int RING_BYTES = 131072, LDS_BYTES = 163840, MISC_OFF = LDS_BYTES - 256;
constexpr int CW_BAR = 4096;
enum { PH_PRO_A = 0, PH_PRO_B = 1, PH_PRO_C = 2, PH_LAYER0 = 3, PH_PER_LAYER = 8, PH_FINAL = PH_LAYER0 + PH_PER_LAYER * L, NPHASE = PH_FINAL + 1 };
enum { LP_IN = 0, LP_H1 = 1, LP_H2 = 2, LP_H3 = 3, LP_OUT = 4, LP_UP = 5, LP_FIX = 6, LP_DOWN = 7 };
struct MKArgs { const float* in[17]; float* out; unsigned char* ws; int ph_lo, ph_hi; };
static_assert(sizeof(MKArgs) == 19 * 8 + 8, "MKArgs has no padding");

__global__ void __launch_bounds__(NTHR, 2) mk_fwd(MKArgs args) {
    extern __shared__ __attribute__((aligned(16))) unsigned char lds_raw[];
    LAS unsigned char* lds = (LAS unsigned char*)lds_raw;
    volatile LAS unsigned* MISC = (volatile LAS unsigned*)(lds + MISC_OFF);
    const int wid_s = __builtin_amdgcn_readfirstlane((int)threadIdx.x >> 6), G = gridDim.x;
#define MK_TID() (wid_s * 64 + lane_id_opaque())
    unsigned char* ws = args.ws;
    for (int u = MK_TID(); u < (LDS_BYTES - RING_BYTES) / 4; u += NTHR) ((LAS unsigned*)(lds + RING_BYTES))[u] = 0u;
    __syncthreads();
    const int lo = args.ph_lo, hi = args.ph_hi;
    XcdBarrier bar; bar.bar = (unsigned*)(ws + O_CTL) + CW_BAR; bar.x = 0; bar.st = nullptr; bar.t0 = false;
    if (hi - lo > 1) bar = xcd_barrier_post((unsigned*)(ws + O_CTL) + CW_BAR, MISC + 8, MK_TID() == 0);
    if (MK_TID() == 0) __hip_atomic_store((unsigned*)(ws + O_CTL) + 8192 + 1024 + blockIdx.x, xb_xcc_id(), __ATOMIC_RELAXED, __HIP_MEMORY_SCOPE_AGENT);
#define IN(k) (lo <= (k) && (k) < hi)
#define SEAM(k) do { if ((k) + 1 < hi) { XcdBarrier bl_ = bar; asm volatile("" : "+s"(bl_.bar), "+s"(bl_.x)); bl_.t0 = (MK_TID() == 0); xcd_barrier(bl_); } } while (0)
#define GSEAM(k) do { if ((k) + 1 < hi) { if (G == 256) { unsigned* gc_ = (unsigned*)(ws + O_CTL); int cq_ = (int)blockIdx.x; asm volatile("" : "+s"(gc_), "+s"(cq_)); \
        group_barrier(gc_, cq_, G, MK_TID() == 0, MISC + 12); } else SEAM(k); } } while (0)
#define PHASE_OPAQUE() size_t zoff_ = 0; int cid = (int)blockIdx.x; asm volatile("" : "+s"(zoff_), "+s"(cid)); unsigned char* wsl = ws + zoff_; const int tid = MK_TID()
    if (IN(PH_PRO_A)) { PHASE_OPAQUE(); pro_a(lds, args.in, wsl, cid, G, tid); SEAM(PH_PRO_A); }
    if (IN(PH_PRO_B)) { PHASE_OPAQUE(); pro_b(args.in, wsl, cid, G, tid);
        pg8::Gemm g{(const bf16_t*)(wsl + O_WTOUT) + 16 * 256 * 64, (const bf16_t*)(wsl + O_WTPL)}; FoldOrder S; S.init(G, cid);
        EpiFold E{(bf16_t*)(wsl + O_WTOUT)};
        pg8::gemm_phase<EpiFold, FoldOrder, 64, 256, 256, 4 * 256 * 64 * 2, PG8_ALIGN, PG8_SP2, false, pg8::NoPre, 256 * 64 * 2, (long)256 * D * 2>(lds, g, S, E, tid);
        SEAM(PH_PRO_B); }
    if (IN(PH_PRO_C)) { PHASE_OPAQUE(); pro_c(lds, args.in, wsl, cid, G, tid); SEAM(PH_PRO_C); }
    for (int l = 0; l < L; ++l) {
        const int base = PH_LAYER0 + PH_PER_LAYER * l;
        if (IN(base + LP_IN)) {
            PHASE_OPAQUE();
            pg8::Gemm g{(const bf16_t*)(wsl + O_XS), (const bf16_t*)(wsl + O_WTIN) + (size_t)l * DIN * D}; pg8::InOrder S; S.init(G, cid);
            const FillRstd<pg8::InOrder> FR{lds, (const float*)(wsl + O_RSS1), &S, tid};
            EpiIn E{(const LAS float*)(lds + RSTD_OFF), (const float*)(wsl + O_SW1) + (size_t)l * NB * DIN, (const float*)(wsl + O_LB) + l * DH,
                    (bf16_t*)(wsl + O_Q), (bf16_t*)(wsl + O_V), (bf16_t*)(wsl + O_SG), (bf16_t*)(wsl + O_U), (_Float16*)(wsl + O_LF)};
            pg8::gemm_phase<EpiIn, pg8::InOrder, 64, 64, D, 0, PG8_ALIGN, PG8_SP2, false, FillRstd<pg8::InOrder>, 256 * 64 * 2, (long)256 * D * 2, false, 256 * 64 * 2, (long)256 * D * 2>(lds, g, S, E, tid, FR);
            hgrn_h1(lds, (const _Float16*)(wsl + O_LF), (const bf16_t*)(wsl + O_V), (bf16_t*)(wsl + O_DS), (float*)(wsl + O_DEC), S, tid);
            SEAM(base + LP_IN);
        }
        if (IN(base + LP_H1)) {
            PHASE_OPAQUE();
            pool_elem((const bf16_t*)(wsl + O_U), (bf16_t*)(wsl + O_YAB), 64, cid, G, tid);
            hgrn_h2(lds, (bf16_t*)(wsl + O_DS), (const float*)(wsl + O_DEC), cid, G, tid);
            SEAM(base + LP_H1);
        }
        if (IN(base + LP_H3)) {
            PHASE_OPAQUE();
            hgrn_h3(lds, (const bf16_t*)(wsl + O_Q), (const _Float16*)(wsl + O_LF), (const bf16_t*)(wsl + O_V), (const bf16_t*)(wsl + O_SG), (const bf16_t*)(wsl + O_DS), args.in[7] + l * HD, (bf16_t*)(wsl + O_YAB), cid, G, tid);
            GSEAM(base + LP_H3);
        }
        if (IN(base + LP_OUT)) {
            PHASE_OPAQUE();
            pg8::Gemm g{(const bf16_t*)(wsl + O_YAB), (const bf16_t*)(wsl + O_WTOUT) + (size_t)l * D * D}; pg8::StaticOrder S; S.init(M, D, G, cid, 4);
            bf16_t* X = (bf16_t*)(wsl + O_X);
            EpiRes E{l == 0 ? (const void*)args.in[0] : (const void*)X, X, (const float*)(wsl + O_MOD) + (size_t)l * NB * 6 * D + 2 * D, (const float*)(wsl + O_GS2) + (size_t)l * NB * D, (bf16_t*)(wsl + O_XS), (float*)(wsl + O_RSS2), l == 0 ? 1 : 0, 0};
            pg8::gemm_phase<EpiRes, pg8::StaticOrder, 64, 64, D, 0, PG8_ALIGN, PG8_SP2, false, pg8::NoPre, 256 * 64 * 2, (long)256 * D * 2, false, 256 * 64 * 2, (long)256 * D * 2>(lds, g, S, E, tid);
            GSEAM(base + LP_OUT);
        }
        if (IN(base + LP_UP)) {
            PHASE_OPAQUE();
            pg8::Gemm g{(const bf16_t*)(wsl + O_XS), (const bf16_t*)(wsl + O_WTUP) + (size_t)l * NUP * D}; pg8::StaticOrder S; S.init(M, NUP, G, cid);
            const FillRstd<pg8::StaticOrder> FR{lds, (const float*)(wsl + O_RSS2), &S, tid};
            EpiUp E{(const LAS float*)(lds + RSTD_OFF), (const float*)(wsl + O_SW2) + (size_t)l * NB * NUP, args.in[13] + (size_t)l * 3 * DFF, args.in[14] + (size_t)l * DFF, (bf16_t*)(wsl + O_ACT), (float*)(wsl + O_HA), (float*)(wsl + O_HV)};
            pg8::gemm_phase<EpiUp, pg8::StaticOrder, 64, 64, D, 0, PG8_ALIGN, PG8_SP2, true, FillRstd<pg8::StaticOrder>, 256 * 64 * 2, (long)256 * D * 2, false, 256 * 64 * 2, (long)256 * D * 2>(lds, g, S, E, tid, FR);
            SEAM(base + LP_UP);
        }
        if (IN(base + LP_FIX)) {
            PHASE_OPAQUE();
            const float* cw = args.in[13] + (size_t)l * 3 * DFF; const float* cb = args.in[14] + (size_t)l * DFF;
            const float* HA = (const float*)(wsl + O_HA); const float* HV = (const float*)(wsl + O_HV); bf16_t* ACT = (bf16_t*)(wsl + O_ACT);
            const bool byg = (G == 256);
            for (int it = byg ? (cid >> 3) * NTHR + tid : cid * NTHR + tid; it < (byg ? 16 : 128) * (DFF / 4); it += (byg ? 32 : G) * NTHR) {
                const int kb = (byg ? 16 * (cid & 7) : 0) + it / (DFF / 4), j = (it % (DFF / 4)) * 4; if ((kb & 31) == 0) continue;
                const f32x4 am2 = *(const f32x4*)(HA + ((size_t)(kb - 1) * 4 + 2) * DFF + j), am1 = *(const f32x4*)(HA + ((size_t)(kb - 1) * 4 + 3) * DFF + j);
                const f32x4 a0 = *(const f32x4*)(HA + ((size_t)kb * 4 + 0) * DFF + j), a1 = *(const f32x4*)(HA + ((size_t)kb * 4 + 1) * DFF + j);
                const f32x4 v0 = *(const f32x4*)(HV + ((size_t)kb * 2 + 0) * DFF + j), v1 = *(const f32x4*)(HV + ((size_t)kb * 2 + 1) * DFF + j);
                const f32x4 cbv = *(const f32x4*)(cb + j), w0 = *(const f32x4*)(cw + j), w1 = *(const f32x4*)(cw + DFF + j), w2 = *(const f32x4*)(cw + 2 * DFF + j);
                const f32x4 c0 = cbv + w0 * am2 + w1 * am1 + w2 * a0, c1 = cbv + w0 * am1 + w1 * a0 + w2 * a1;
                const f32x4 o0 = silu4(c0) * v0, o1 = silu4(c1) * v1;
                u32x2 p0, p1; p0.x = cvt_pk_bf16(o0.x, o0.y); p0.y = cvt_pk_bf16(o0.z, o0.w); p1.x = cvt_pk_bf16(o1.x, o1.y); p1.y = cvt_pk_bf16(o1.z, o1.w);
                bf16_t* ap = ACT + (size_t)(kb >> 1) * (256 * DFF) + (size_t)(j >> 6) * (256 * 64) + (128 * (kb & 1)) * 64 + (j & 63);
                *(u32x2*)ap = p0; *(u32x2*)(ap + 64) = p1;
            }
            GSEAM(base + LP_FIX);
        }
        if (IN(base + LP_DOWN)) {
            PHASE_OPAQUE();
            pg8::Gemm g{(const bf16_t*)(wsl + O_ACT), (const bf16_t*)(wsl + O_WTDN) + (size_t)l * D * DFF}; pg8::StaticOrder S; S.init(M, D, G, cid, 4);
            const bool lastl = (l == L - 1); bf16_t* X = (bf16_t*)(wsl + O_X);
            EpiRes E{X, (void*)X, (const float*)(wsl + O_MOD) + (size_t)l * NB * 6 * D + 5 * D, (const float*)(wsl + O_GS1) + (size_t)(lastl ? 0 : l + 1) * NB * D, lastl ? (bf16_t*)nullptr : (bf16_t*)(wsl + O_XS), (float*)(wsl + O_RSS1), 0, 0};
            pg8::gemm_phase<EpiRes, pg8::StaticOrder, 64, 64, DFF, 0, PG8_ALIGN, PG8_SP2, false, pg8::NoPre, 256 * 64 * 2, (long)256 * DFF * 2, true, 256 * 64 * 2, (long)256 * DFF * 2>(lds, g, S, E, tid);
            GSEAM(base + LP_DOWN);
        }
    }
    if (IN(PH_FINAL)) {
        PHASE_OPAQUE();
        const float* RSS1 = (const float*)(wsl + O_RSS1); const float* fin_g = args.in[16]; const bf16_t* X = (const bf16_t*)(wsl + O_X);
        const int lane = tid & 63, wv = wid_s;
        const bool byg = (G == 256);
        for (int row = byg ? 2048 * (cid & 7) + (cid >> 3) * NWAVES + wv : cid * NWAVES + wv; row < (byg ? 2048 * (cid & 7) + 2048 : M); row += (byg ? 32 : G) * NWAVES) {
            float s = (lane < 32) ? RSS1[(size_t)row * 32 + lane] : 0.f;
#pragma unroll
            for (int o = 32; o >= 1; o >>= 1) s += bperm(s, lane ^ o);
            const float r = rsqrtf(s * (1.f / D) + EPS);
            float* orow = args.out + (size_t)row * D; const bf16_t* xrow = X + (size_t)row * D;
#pragma unroll
            for (int j = 0; j < 4; ++j) { const int c = j * 512 + lane * 8; const f16x8_t hh = *(const f16x8_t*)(xrow + c); const f32x8_t ff = __builtin_convertvector(hh, f32x8_t);
                const f32x4 g0 = *(const f32x4*)(fin_g + c), g1 = *(const f32x4*)(fin_g + c + 4);
                *(f32x4*)(orow + c) = (f32x4){ff[0], ff[1], ff[2], ff[3]} * r * g0; *(f32x4*)(orow + c + 4) = (f32x4){ff[4], ff[5], ff[6], ff[7]} * r * g1; }
        }
    }
#undef PHASE_OPAQUE
#undef IN
#undef SEAM
}

static void mk_launch(const MKArgs& base, int lo, int hi, int grid, hipStream_t stream) {
    MKArgs a = base; a.ph_lo = lo; a.ph_hi = hi;
    hipLaunchKernelGGL(mk_fwd, dim3(grid), dim3(NTHR), LDS_BYTES, stream, a);
}

extern "C" void kernel_launch(void* const* d_in, const int* in_sizes, int n_in, void* d_out, int out_size, void* d_ws, size_t ws_size, hipStream_t stream) {
    static int grid = 0;
    if (grid == 0) {
        if (n_in != 17 || ws_size < WS_END) { fprintf(stderr, "kernel_launch: unexpected n_in %d or ws_size %zu < %zu\n", n_in, ws_size, (size_t)WS_END); grid = -1; return; }
        int dev = 0, cus = 0;
        if (hipGetDevice(&dev) != hipSuccess || hipDeviceGetAttribute(&cus, hipDeviceAttributeMultiprocessorCount, dev) != hipSuccess) { grid = -1; return; }
        if (hipFuncSetAttribute((const void*)mk_fwd, hipFuncAttributeMaxDynamicSharedMemorySize, LDS_BYTES) != hipSuccess) { fprintf(stderr, "kernel_launch: hipFuncSetAttribute failed\n"); grid = -1; return; }
        int per_cu = 0; (void)hipOccupancyMaxActiveBlocksPerMultiprocessor(&per_cu, (const void*)mk_fwd, NTHR, LDS_BYTES); (void)hipGetLastError();
        grid = cus;
    }
    if (grid < 0) return;
    char* ws = (char*)d_ws; float* out = (float*)d_out;
    (void)hipMemsetAsync(ws + O_CTL, 0, SZ_CTL, stream);
    MKArgs a{}; for (int i = 0; i < 17; ++i) a.in[i] = (const float*)d_in[i]; a.out = out; a.ws = (unsigned char*)d_ws;

    mk_launch(a, 0, NPHASE, grid, stream);
}
```

```cpp
#include <hip/hip_runtime.h>
#include <stdint.h>
#include <stdio.h>

namespace cfg {
constexpr int D = 2048, NB = 4, SEQ = 4096, L = 4, M = NB * SEQ;
constexpr int DH = 1024, HD = 128, NH = 8, DP = 1024, DIN = 5120, DFF = 5632, NUP = 11264, CH = 64, NCH = SEQ / CH;
constexpr float EPS = 1e-6f;
constexpr float QSCALE = 0.08838834764831845f;
}
using namespace cfg;

typedef unsigned short bf16_t;
typedef short bf16x8 __attribute__((ext_vector_type(8)));
typedef float f32x4 __attribute__((ext_vector_type(4)));
typedef unsigned u32x4 __attribute__((ext_vector_type(4)));
typedef unsigned u32x2 __attribute__((ext_vector_type(2)));

__device__ __forceinline__ bf16_t f2bf(float f) { unsigned u = __float_as_uint(f); u += 0x7fffu + ((u >> 16) & 1u); return (bf16_t)(u >> 16); }
__device__ __forceinline__ float bf2f(bf16_t b) { return __uint_as_float(((unsigned)b) << 16); }
__device__ __forceinline__ unsigned pk2(float lo, float hi) { return (unsigned)f2bf(lo) | ((unsigned)f2bf(hi) << 16); }
typedef float f32x2_t __attribute__((ext_vector_type(2)));
typedef __bf16 bf16x2_t __attribute__((ext_vector_type(2)));
__device__ __forceinline__ unsigned cvt_pk_bf16_c(float lo, float hi) { const f32x2_t v = {lo, hi}; return __builtin_bit_cast(unsigned, __builtin_convertvector(v, bf16x2_t)); }
__device__ __forceinline__ unsigned cvt_pk_bf16(float lo, float hi) { unsigned r; asm volatile("v_cvt_pk_bf16_f32 %0, %1, %2" : "=v"(r) : "v"(lo), "v"(hi)); return r; }
__device__ __forceinline__ float bperm(float v, int src_lane) { return __int_as_float(__builtin_amdgcn_ds_bpermute(src_lane << 2, __float_as_int(v))); }
__device__ __forceinline__ float siluf(float x) { return x * __builtin_amdgcn_rcpf(1.f + __expf(-x)); }
__device__ __forceinline__ float logf_of(float p, float lb) { const float sig = __builtin_amdgcn_rcpf(1.f + __expf(-p)); const float f = lb + (1.f - lb) * sig; return fmaxf(__logf(f), -60.f); }

constexpr size_t al256(size_t x) { return (x + 255) & ~(size_t)255; }
constexpr size_t O_CTL = 0, SZ_CTL = 1u << 20;
constexpr size_t O_MOD = O_CTL + SZ_CTL,                 SZ_MOD = (size_t)L * NB * 6 * D * 4;
constexpr size_t O_LB = O_MOD + al256(SZ_MOD),           SZ_LB = (size_t)L * DH * 4;
constexpr size_t O_GS1 = O_LB + al256(SZ_LB),            SZ_GS = (size_t)L * NB * D * 4;
constexpr size_t O_GS2 = O_GS1 + al256(SZ_GS);
constexpr size_t O_SW1 = O_GS2 + al256(SZ_GS),           SZ_SW1 = (size_t)L * NB * DIN * 4;
constexpr size_t O_SW2 = O_SW1 + al256(SZ_SW1),          SZ_SW2 = (size_t)L * NB * NUP * 4;
constexpr size_t O_RSS1 = O_SW2 + al256(SZ_SW2),         SZ_RSS = (size_t)M * 32 * 4;
constexpr size_t O_RSS2 = O_RSS1 + al256(SZ_RSS);
constexpr size_t O_WTIN = O_RSS2 + al256(SZ_RSS),        SZ_WTIN = (size_t)L * DIN * D * 2;
constexpr size_t O_WTOUT = O_WTIN + al256(SZ_WTIN),      SZ_WTOUT = (size_t)L * D * D * 2;
constexpr size_t O_WTUP = O_WTOUT + al256(SZ_WTOUT),     SZ_WTUP = (size_t)L * NUP * D * 2;
constexpr size_t O_WTDN = O_WTUP + al256(SZ_WTUP),       SZ_WTDN = (size_t)L * D * DFF * 2;
constexpr size_t O_WTPL = O_WTDN + al256(SZ_WTDN),       SZ_WTPL = (size_t)L * 4 * 256 * 256 * 2;
constexpr size_t O_X = O_WTPL + al256(SZ_WTPL),          SZ_X = (size_t)M * D * 4;
constexpr size_t O_XS = O_X + al256(SZ_X),               SZ_XS = (size_t)M * D * 2;
constexpr size_t O_ACT = O_XS + al256(SZ_XS),            SZ_ACT = (size_t)M * DFF * 2;
constexpr size_t O_HA = O_ACT + al256(SZ_ACT),           SZ_HA = (size_t)256 * 4 * DFF * 4;
constexpr size_t O_HV = O_HA + al256(SZ_HA),             SZ_HV = (size_t)256 * 2 * DFF * 4;
constexpr size_t O_MODP = O_HV + al256(SZ_HV),           SZ_MODP = (size_t)32 * L * NB * 6 * D * 4;
constexpr size_t O_MIX = O_MODP + al256(SZ_MODP);
constexpr size_t SZ_H16 = (size_t)M * DH * 2;
constexpr size_t O_Q = O_MIX, O_V = O_Q + SZ_H16, O_SG = O_V + SZ_H16, O_U = O_SG + SZ_H16, O_PU = O_U + SZ_H16;
constexpr size_t O_LF = O_PU + SZ_H16,                   SZ_LF = (size_t)M * DH * 4;
constexpr size_t O_YAB = O_LF + SZ_LF,                   SZ_YAB = (size_t)M * D * 2;
constexpr size_t O_DS = O_YAB + SZ_YAB,                  SZ_DS = (size_t)NB * NH * NCH * HD * HD * 2;
constexpr size_t O_DEC = O_DS + SZ_DS,                   SZ_DEC = (size_t)NB * NH * NCH * HD * 4;
constexpr size_t O_MIXEND = O_DEC + al256(SZ_DEC);
constexpr size_t WS_END = O_MIXEND;
static_assert(WS_END < (size_t)1470 * 1000 * 1000, "workspace map exceeds the guaranteed d_ws size");

__host__ __device__ __forceinline__ int up_rowmap(int n) { return n < DFF ? 256 * (n / 128) + (n % 128) : 256 * ((n - DFF) / 128) + 128 + ((n - DFF) % 128); }

__device__ __forceinline__ int lane_id_opaque() { int l; asm volatile("v_mbcnt_lo_u32_b32 %0, -1, 0\n\tv_mbcnt_hi_u32_b32 %0, -1, %0" : "=v"(l)); return l; }
namespace pg8 {
#define PG8_LAS __attribute__((address_space(3)))
constexpr int BM = 256, BK = 64, HALF = 128, HTB = HALF * BK * 2  , STAGE_BYTES = 8 * HTB, NXCD = 8;
__host__ __device__ __forceinline__ int lds_byte(int r, int c) { const int st = (r >> 4) * 2 + (c >> 5), rr = r & 15, cc = c & 31, ob = rr * 64 + cc * 2; return st * 1024 + (ob ^ (((ob >> 9) & 1) << 5)); }
__host__ __device__ __forceinline__ void stage_rc(int b, int& R, int& C) { const int st = b / 1024, sb = b % 1024, swz = sb ^ (((sb >> 9) & 1) << 5); R = (st >> 1) * 16 + swz / 64; C = (st & 1) * 32 + (swz % 64) / 2; }
__host__ __device__ __forceinline__ int perm32(int rho) { const int n = rho >> 4, i = rho & 15; return 8 * (i >> 2) + 4 * n + (i & 3); }

struct Unit { int pm, pn; };
struct Gemm { const bf16_t* A; const bf16_t* Bt; };

struct StaticOrder {
    int nM, nN, nwg, G, c, WGM;
    __host__ __device__ void init(int M, int N, int G_, int c_, int wgm = 8) { nM = M / BM; nN = N / BM; nwg = nM * nN; G = G_; c = c_; WGM = wgm; }
    __host__ __device__ bool next(int i, Unit& u) const {
        const long Lx = (long)i * G + c; if (Lx >= nwg) return false;
        int wgid = (int)Lx; { const int q = nwg / NXCD, r = nwg % NXCD, xcd = wgid % NXCD, off = wgid / NXCD; wgid = (xcd < r ? xcd * (q + 1) : r * (q + 1) + (xcd - r) * q) + off; }
        const int nig = WGM * nN, gid = wgid / nig, fm = gid * WGM, gsz = (nM - fm) < WGM ? (nM - fm) : WGM;
        u.pm = fm + ((wgid % nig) % gsz); u.pn = (wgid % nig) / gsz; return true;
    }
    __device__ __forceinline__ size_t b_off(const Unit&) const { return 0; }
    __device__ __forceinline__ void a_ready(const Unit&) const {}
    __device__ __forceinline__ void done(const Unit&) const {}
};

struct InOrder {
    int vid, G;
    __host__ __device__ __forceinline__ void init(int G_, int c) { G = G_; vid = (G_ % 8 == 0) ? (c % 8) * (G_ / 8) + c / 8 : c; }
    __host__ __device__ __forceinline__ bool next(int i, Unit& u) const { const int vv = vid + (i / 5) * G; if (vv >= 256) return false; u.pm = vv >> 2; u.pn = (vv & 3) + 4 * (i % 5); return true; }
    __device__ __forceinline__ size_t b_off(const Unit&) const { return 0; }
    __device__ __forceinline__ void a_ready(const Unit&) const {}
    __device__ __forceinline__ void done(const Unit&) const {}
    __host__ __device__ __forceinline__ int item(int k) const { const int vv = vid + (k >> 3) * G; if (vv >= 256) return -1; const int pm = vv >> 2, p = vv & 3, j = k & 7; return (((pm >> 4) * 8 + 2 * p + (j >> 2)) << 6) + (pm & 15) * 4 + (j & 3); }
};
struct NoPre { __device__ __forceinline__ void operator()() const {} };
template <class Epi, class Sched, int LDA, int LDB, int KK, int APN, bool ALIGN_EPI = false, bool SP2 = false, bool ROWP = false, class Pre = NoPre, long KSA = 0, long TSA = 0, bool KREV = false, long KSB = 0, long TSB = 0>
__device__ __forceinline__ void gemm_phase(PG8_LAS unsigned char* lds, const Gemm g, const Sched& S, const Epi& E, int tid_in, const Pre& P = Pre()) {
    int tid_o = tid_in; asm volatile("" : "+v"(tid_o));
    const int tid = tid_o, wid = __builtin_amdgcn_readfirstlane(tid >> 6), lane = tid & 63, wr = wid >> 2, wc = wid & 3, fr = lane & 15, fq = lane >> 4;
    constexpr int nt = KK / BK;
    unsigned voffA[2], voffB[2];
#pragma unroll
    for (int i = 0; i < 2; ++i) { int R, C; stage_rc(tid * 16 + i * 8192, R, C); const int Rb = Epi::PERM ? ((R & ~31) + perm32(R & 31)) : R;
        const int Ra = ROWP ? (128 * (R >> 6) + 8 * (R & 15) + ((R >> 4) & 3)) : R;
        voffA[i] = (unsigned)(Ra * LDA + C) * 2u; voffB[i] = (unsigned)(Rb * LDB + C) * 2u; }
    constexpr ptrdiff_t kstep0 = KSB ? (ptrdiff_t)KSB : (ptrdiff_t)(BK * 2), kstepA0 = KSA ? (ptrdiff_t)KSA : (ptrdiff_t)(BK * 2), kstep = KREV ? -kstep0 : kstep0, kstepA = KREV ? -kstepA0 : kstepA0;
    constexpr ptrdiff_t kofB = KREV ? (ptrdiff_t)(KK / BK - 1) * kstep0 : 0, kofA = KREV ? (ptrdiff_t)(KK / BK - 1) * kstepA0 : 0;
    constexpr size_t hstepA = (size_t)(ROWP ? 4 : HALF) * LDA * 2, hstepB = (size_t)HALF * LDB * 2;
    constexpr size_t tstepA = TSA ? (size_t)TSA : (size_t)2 * HALF * LDA * 2, tstepB = TSB ? (size_t)TSB : 2 * hstepB;
    const unsigned ldsw = (unsigned)wid * 1024u;
    const int aoff = lds_byte(wr * 64 + fr, fq * 8), boff = lds_byte(wc * 32 + fr, fq * 8);
#define PG8_SA(b, h) (((b) * 2 + (h)) * HTB)
#define PG8_SB(b, h) ((4 + (b) * 2 + (h)) * HTB)
#define PG8_STAGE(bufoff, gbase, voff) do { _Pragma("unroll") for (int _i = 0; _i < 2; ++_i) \
        __builtin_amdgcn_global_load_lds((const unsigned*)((const char*)(gbase) + (voff)[_i]), (PG8_LAS unsigned*)(lds + (bufoff) + ldsw + _i * 8192), 16, 0, 0); } while (0)
#define PG8_LDA(dst, b, h) do { _Pragma("unroll") for (int m = 0; m < 4; ++m) _Pragma("unroll") for (int k = 0; k < 2; ++k) dst[m][k] = *(const PG8_LAS bf16x8*)(lds + PG8_SA(b, h) + aoff + m * 2048 + k * 1024); } while (0)
#define PG8_LDB(dst, b, h) do { _Pragma("unroll") for (int n = 0; n < 2; ++n) _Pragma("unroll") for (int k = 0; k < 2; ++k) dst[n][k] = *(const PG8_LAS bf16x8*)(lds + PG8_SB(b, h) + boff + n * 2048 + k * 1024); } while (0)
#define PG8_MMA(ai, bj, At, Bt) do { __builtin_amdgcn_s_setprio(1); _Pragma("unroll") for (int m = 0; m < 4; ++m) _Pragma("unroll") for (int n = 0; n < 2; ++n) _Pragma("unroll") for (int k = 0; k < 2; ++k) \
        acc[ai][bj][m][n] = __builtin_amdgcn_mfma_f32_16x16x32_bf16(Bt[n][k], At[m][k], acc[ai][bj][m][n], 0, 0, 0); __builtin_amdgcn_s_setprio(0); } while (0)
#define PG8_WAIT_V(n) asm volatile("s_waitcnt vmcnt(" #n ")" ::: "memory")
#define PG8_WAIT_L(n) asm volatile("s_waitcnt lgkmcnt(" #n ")" ::: "memory")
#define PG8_BAR __builtin_amdgcn_s_barrier()
#define PG8_SCHED __builtin_amdgcn_sched_barrier(0)
    Unit cur, nxt; int ui = 0;
    if (!S.next(0, cur)) return;
    f32x4 acc[2][2][4][2];
#pragma unroll
    for (int a = 0; a < 2; ++a)
#pragma unroll
        for (int b = 0; b < 2; ++b)
#pragma unroll
            for (int m = 0; m < 4; ++m)
#pragma unroll
                for (int n = 0; n < 2; ++n) acc[a][b][m][n] = (f32x4){0.f, 0.f, 0.f, 0.f};
    bf16x8 At[4][2], B0[2][2], B1[2][2];
    const char* cA = (const char*)g.A + (size_t)cur.pm * tstepA + (size_t)cur.pn * APN + kofA; const char* cB = (const char*)g.Bt + (size_t)cur.pn * tstepB + S.b_off(cur) + kofB;
    S.a_ready(cur);
    if constexpr (SP2) {
        PG8_STAGE(PG8_SB(0, 0), cB, voffB); PG8_STAGE(PG8_SB(0, 1), cB + hstepB, voffB); PG8_STAGE(PG8_SA(0, 0), cA, voffA); PG8_STAGE(PG8_SA(0, 1), cA + hstepA, voffA);
        P();
        if (wr == 1) PG8_BAR;
        PG8_WAIT_V(2); PG8_BAR;
        PG8_STAGE(PG8_SB(1, 0), cB + kstep, voffB); PG8_STAGE(PG8_SA(1, 0), cA + kstepA, voffA); PG8_STAGE(PG8_SB(1, 1), cB + hstepB + kstep, voffB);
        PG8_WAIT_V(6); PG8_BAR;
    } else {
        PG8_STAGE(PG8_SB(0, 0), cB, voffB); PG8_STAGE(PG8_SA(0, 0), cA, voffA); PG8_STAGE(PG8_SB(0, 1), cB + hstepB, voffB); PG8_STAGE(PG8_SA(0, 1), cA + hstepA, voffA);
        if (wr == 1) PG8_BAR;
        PG8_WAIT_V(4); PG8_BAR;
        PG8_STAGE(PG8_SB(1, 0), cB + kstep, voffB); PG8_STAGE(PG8_SA(1, 0), cA + kstepA, voffA); PG8_STAGE(PG8_SB(1, 1), cB + hstepB + kstep, voffB);
        PG8_WAIT_V(6); PG8_BAR;
    }
    for (;;) {
        const bool has_next = S.next(ui + 1, nxt);
        const char* nA = has_next ? (const char*)g.A + (size_t)nxt.pm * tstepA + (size_t)nxt.pn * APN + kofA : cA; const char* nB = has_next ? (const char*)g.Bt + (size_t)nxt.pn * tstepB + S.b_off(nxt) + kofB : cB;
        for (int t = 0; t < nt; t += 2) {
            const bool last = (t == nt - 2);
            const char* a1 = cA + (ptrdiff_t)(t + 1) * kstepA;
            const char* a2 = last ? nA : cA + (ptrdiff_t)(t + 2) * kstepA; const char* b2 = last ? nB : cB + (ptrdiff_t)(t + 2) * kstep;
            const char* a3 = a2 + kstepA; const char* b3 = b2 + kstep;
            if (last && has_next) S.a_ready(nxt);
            if constexpr (SP2) {
            PG8_LDB(B0, 0, 0); PG8_LDB(B1, 0, 1); PG8_SCHED; PG8_LDA(At, 0, 0); PG8_STAGE(PG8_SA(1, 1), a1 + hstepA, voffA);
            PG8_WAIT_V(8); PG8_WAIT_L(0); PG8_BAR; PG8_MMA(0, 0, At, B0); PG8_MMA(0, 1, At, B1); PG8_BAR; PG8_SCHED;
            PG8_LDA(At, 0, 1); PG8_STAGE(PG8_SB(0, 0), b2, voffB); PG8_STAGE(PG8_SB(0, 1), b2 + hstepB, voffB); PG8_STAGE(PG8_SA(0, 0), a2, voffA);
            PG8_WAIT_V(8); PG8_WAIT_L(0); PG8_BAR; PG8_MMA(1, 0, At, B0); PG8_MMA(1, 1, At, B1); PG8_BAR; PG8_SCHED;
            PG8_LDB(B0, 1, 0); PG8_LDB(B1, 1, 1); PG8_SCHED; PG8_LDA(At, 1, 0); PG8_STAGE(PG8_SA(0, 1), a2 + hstepA, voffA);
            PG8_WAIT_V(8); PG8_WAIT_L(0); PG8_BAR; PG8_MMA(0, 0, At, B0); PG8_MMA(0, 1, At, B1); PG8_BAR; PG8_SCHED;
            PG8_LDA(At, 1, 1); PG8_STAGE(PG8_SB(1, 0), b3, voffB); PG8_STAGE(PG8_SB(1, 1), b3 + hstepB, voffB); PG8_STAGE(PG8_SA(1, 0), a3, voffA);
            PG8_WAIT_V(8); PG8_WAIT_L(0); PG8_BAR; PG8_MMA(1, 0, At, B0); PG8_MMA(1, 1, At, B1); PG8_BAR; PG8_SCHED;
            } else {
            PG8_LDB(B0, 0, 0); PG8_SCHED; PG8_LDA(At, 0, 0); PG8_STAGE(PG8_SA(1, 1), a1 + hstepA, voffA);
            PG8_WAIT_L(8); PG8_BAR; PG8_WAIT_L(0); PG8_MMA(0, 0, At, B0); PG8_BAR; PG8_SCHED;
            PG8_LDB(B1, 0, 1); PG8_STAGE(PG8_SB(0, 0), b2, voffB);
            PG8_BAR; PG8_WAIT_L(0); PG8_MMA(0, 1, At, B1); PG8_BAR;
            PG8_LDA(At, 0, 1); PG8_STAGE(PG8_SA(0, 0), a2, voffA);
            PG8_BAR; PG8_WAIT_L(0); PG8_MMA(1, 0, At, B0); PG8_BAR; PG8_SCHED;
            PG8_STAGE(PG8_SB(0, 1), b2 + hstepB, voffB);
            PG8_WAIT_V(6); PG8_BAR; PG8_MMA(1, 1, At, B1); PG8_BAR;
            PG8_LDB(B0, 1, 0); PG8_SCHED; PG8_LDA(At, 1, 0); PG8_STAGE(PG8_SA(0, 1), a2 + hstepA, voffA);
            PG8_WAIT_L(8); PG8_BAR; PG8_WAIT_L(0); PG8_MMA(0, 0, At, B0); PG8_BAR; PG8_SCHED;
            PG8_LDB(B1, 1, 1); PG8_STAGE(PG8_SB(1, 0), b3, voffB);
            PG8_BAR; PG8_WAIT_L(0); PG8_MMA(0, 1, At, B1); PG8_BAR;
            PG8_LDA(At, 1, 1); PG8_STAGE(PG8_SA(1, 0), a3, voffA);
            PG8_BAR; PG8_WAIT_L(0); PG8_MMA(1, 0, At, B0); PG8_BAR; PG8_SCHED;
            PG8_STAGE(PG8_SB(1, 1), b3 + hstepB, voffB);
            PG8_WAIT_V(6); PG8_BAR; PG8_MMA(1, 1, At, B1); PG8_BAR;
            }
        }
        if constexpr (ALIGN_EPI) { if (wr == 0) PG8_BAR; }
        { const int l2 = lane_id_opaque(); E(acc, cur, ui, wr, wc, l2 & 15, l2 >> 4); }
        S.done(cur);
        if (!has_next) break;
#pragma unroll
        for (int a = 0; a < 2; ++a)
#pragma unroll
            for (int b = 0; b < 2; ++b)
#pragma unroll
                for (int m = 0; m < 4; ++m)
#pragma unroll
                    for (int n = 0; n < 2; ++n) acc[a][b][m][n] = (f32x4){0.f, 0.f, 0.f, 0.f};
        cur = nxt; cA = nA; cB = nB; ++ui;
        if constexpr (ALIGN_EPI) { if (wr == 1) PG8_BAR; }
    }
    PG8_WAIT_V(0);
    if constexpr (!ALIGN_EPI) { if (wr == 0) PG8_BAR; }
    PG8_BAR;
#undef PG8_SA
#undef PG8_SB
#undef PG8_STAGE
#undef PG8_LDA
#undef PG8_LDB
#undef PG8_MMA
#undef PG8_WAIT_V
#undef PG8_WAIT_L
#undef PG8_BAR
#undef PG8_SCHED
}
}

#ifndef PG8_SP2
#define PG8_SP2 true
#endif
#ifndef PG8_ALIGN
#define PG8_ALIGN true
#endif

#define LAS __attribute__((address_space(3)))
constexpr int RSTD_OFF = 131072 + 1024;
template <class Sched> __device__ __forceinline__ void fill_rstd(LAS unsigned char* lds, const float* RSS, const Sched& S, int tid) {
    LAS float* T = (LAS float*)(lds + RSTD_OFF); const int row = tid & 255; pg8::Unit u;
    int prev_pm = -1; float prev = 0.f;
    for (int i = tid >> 8; S.next(i, u); i += 2) {
        if (u.pm != prev_pm) { const float* p = RSS + (size_t)(u.pm * 256 + row) * 32; float s_ = 0.f;
#pragma unroll
            for (int j = 0; j < 8; ++j) { const f32x4 a = *(const f32x4*)(p + 4 * j); s_ += (a.x + a.y) + (a.z + a.w); }
            prev = rsqrtf(s_ * (1.f / D) + EPS); prev_pm = u.pm; }
        T[i * 256 + row] = prev; }
    __syncthreads();
}
template <class Sched> struct FillRstd { LAS unsigned char* lds; const float* RSS; const Sched* S; int tid;
    __device__ __forceinline__ void operator()() const { fill_rstd(lds, RSS, *S, tid); } };
__device__ __forceinline__ u32x4 pack8(const f32x4 a, const f32x4 b) { u32x4 w; w.x = cvt_pk_bf16(a.x, a.y); w.y = cvt_pk_bf16(a.z, a.w); w.z = cvt_pk_bf16(b.x, b.y); w.w = cvt_pk_bf16(b.z, b.w); return w; }
__device__ __forceinline__ f32x4 silu4(const f32x4 p) { f32x4 r; r.x = siluf(p.x); r.y = siluf(p.y); r.z = siluf(p.z); r.w = siluf(p.w); return r; }

typedef _Float16 f16x8_t __attribute__((ext_vector_type(8)));
typedef float f32x8_t __attribute__((ext_vector_type(8)));
__host__ __device__ __forceinline__ size_t xs_off(int row, int col) { return (size_t)(row >> 8) * (256 * D) + (size_t)(col >> 6) * (256 * 64) + (size_t)((row & 255) * 64 + (col & 63)); }
struct EpiIn {
    static constexpr bool PERM = true;
    const LAS float* RSTD; const float* SW; const float* LBl; bf16_t *Q, *V, *SG, *U; _Float16* LF;
    __device__ __forceinline__ void operator()(f32x4 (&acc)[2][2][4][2], const pg8::Unit& u, int ui, int wr, int wc, int fr, int fq) const {
        const int b = u.pm >> 4, grp = u.pn >> 2;
        const int row0 = u.pm * 256 + wr * 64 + fr, colt = (u.pn & 3) * 256 + wc * 32 + fq * 8, gcol = u.pn * 256 + wc * 32 + fq * 8;
        f32x4 sw[2][2], lb[2][2];
#pragma unroll
        for (int bj = 0; bj < 2; ++bj)
#pragma unroll
            for (int n = 0; n < 2; ++n) { sw[bj][n] = *(const f32x4*)(SW + (size_t)b * DIN + gcol + bj * 128 + n * 4); lb[bj][n] = (grp == 1) ? *(const f32x4*)(LBl + colt + bj * 128 + n * 4) : (f32x4){0.f, 0.f, 0.f, 0.f}; }
#pragma unroll
        for (int ai = 0; ai < 2; ++ai)
#pragma unroll
            for (int m = 0; m < 4; ++m) {
                const int row = row0 + ai * 128 + m * 16; const float r = RSTD[ui * 256 + ai * 128 + wr * 64 + m * 16 + fr];
#pragma unroll
                for (int bj = 0; bj < 2; ++bj) {
                    f32x4 p0 = acc[ai][bj][m][0] * r + sw[bj][0], p1 = acc[ai][bj][m][1] * r + sw[bj][1];
                    const size_t o = (size_t)row * DH + colt + bj * 128;
                    if (grp == 0) { *(u32x4*)(Q + o) = pack8(silu4(p0) * QSCALE, silu4(p1) * QSCALE); }
                    else if (grp == 1) { f32x4 l0, l1; l0.x = logf_of(p0.x, lb[bj][0].x); l0.y = logf_of(p0.y, lb[bj][0].y); l0.z = logf_of(p0.z, lb[bj][0].z); l0.w = logf_of(p0.w, lb[bj][0].w);
                        l1.x = logf_of(p1.x, lb[bj][1].x); l1.y = logf_of(p1.y, lb[bj][1].y); l1.z = logf_of(p1.z, lb[bj][1].z); l1.w = logf_of(p1.w, lb[bj][1].w);
                        const f32x8_t ff = {l0.x, l0.y, l0.z, l0.w, l1.x, l1.y, l1.z, l1.w}; *(f16x8_t*)(LF + o) = __builtin_convertvector(ff, f16x8_t); }
                    else if (grp == 2) { *(u32x4*)(V + o) = pack8(p0, p1); }
                    else if (grp == 3) { *(u32x4*)(SG + o) = pack8(silu4(p0), silu4(p1)); }
                    else { *(u32x4*)(U + o) = pack8(p0, p1); }
                }
            }
    }
};
struct FoldOrder {
    int G, c;
    __host__ __device__ __forceinline__ void init(int G_, int c_) { G = G_; c = c_; }
    __host__ __device__ __forceinline__ bool next(int i, pg8::Unit& u) const { const long Lx = (long)i * G + c; if (Lx >= 128) return false; const int Lq = (int)Lx; u.pm = 8 * (Lq >> 5) + (Lq & 7); u.pn = (Lq >> 3) & 3; return true; }
    __device__ __forceinline__ size_t b_off(const pg8::Unit& u) const { return (size_t)(u.pm >> 3) * 4 * 131072; }
    __device__ __forceinline__ void a_ready(const pg8::Unit&) const {}
    __device__ __forceinline__ void done(const pg8::Unit&) const {}
};
struct EpiFold {
    static constexpr bool PERM = true;
    bf16_t* WT;
    __device__ __forceinline__ void operator()(f32x4 (&acc)[2][2][4][2], const pg8::Unit& u, int ui, int wr, int wc, int fr, int fq) const {
        const int row0 = u.pm * 256 + wr * 64 + fr, col = DH + u.pn * 256 + wc * 32 + fq * 8;
        float one = 1.f; asm volatile("" : "+v"(one));
#pragma unroll
        for (int ai = 0; ai < 2; ++ai)
#pragma unroll
            for (int m = 0; m < 4; ++m) { const int row = row0 + ai * 128 + m * 16;
#pragma unroll
                for (int bj = 0; bj < 2; ++bj) *(u32x4*)(WT + xs_off(row, col + bj * 128)) = pack8(acc[ai][bj][m][0] * one, acc[ai][bj][m][1] * one); }
    }
};
struct EpiRes {
    static constexpr bool PERM = true;
    const void* xin; void* xout; const float* gate; const float* GS; bf16_t* XS; float* RSS; int in_f32, out_f32;
    template <bool INF32, int M0, int M1> __device__ __forceinline__ void half(f32x4 (&acc)[2][2][4][2], int ai, int b, int row0, int col, int pn, int wc, int fr, int fq) const {
        f32x4 xv[4][2][2];
        if (INF32) {
#pragma unroll
            for (int m = M0; m < M1; ++m)
#pragma unroll
                for (int bj = 0; bj < 2; ++bj) { const float* p = (const float*)xin + (size_t)(row0 + ai * 128 + m * 16) * D + col + bj * 128; xv[m][bj][0] = *(const f32x4*)p; xv[m][bj][1] = *(const f32x4*)(p + 4); }
        } else {
            f16x8_t hh[4][2];
#pragma unroll
            for (int m = M0; m < M1; ++m)
#pragma unroll
                for (int bj = 0; bj < 2; ++bj) hh[m][bj] = *(const f16x8_t*)((const bf16_t*)xin + (size_t)(row0 + ai * 128 + m * 16) * D + col + bj * 128);
#pragma unroll
            for (int m = M0; m < M1; ++m)
#pragma unroll
                for (int bj = 0; bj < 2; ++bj) { const f32x8_t ff = __builtin_convertvector(hh[m][bj], f32x8_t); xv[m][bj][0] = (f32x4){ff[0], ff[1], ff[2], ff[3]}; xv[m][bj][1] = (f32x4){ff[4], ff[5], ff[6], ff[7]}; }
        }
        f32x4 gt[2][2], gs[2][2];
#pragma unroll
        for (int bj = 0; bj < 2; ++bj)
#pragma unroll
            for (int n = 0; n < 2; ++n) { gt[bj][n] = *(const f32x4*)(gate + (size_t)b * 6 * D + col + bj * 128 + n * 4); gs[bj][n] = XS ? *(const f32x4*)(GS + (size_t)b * D + col + bj * 128 + n * 4) : (f32x4){0.f, 0.f, 0.f, 0.f}; }
        __builtin_amdgcn_sched_barrier(0);
#pragma unroll
        for (int m = M0; m < M1; ++m) { const int row = row0 + ai * 128 + m * 16; float ss = 0.f;
#pragma unroll
            for (int bj = 0; bj < 2; ++bj) { const size_t o = (size_t)row * D + col + bj * 128;
                const f32x4 x0 = xv[m][bj][0] + gt[bj][0] * acc[ai][bj][m][0], x1 = xv[m][bj][1] + gt[bj][1] * acc[ai][bj][m][1];
                if (out_f32) { *(f32x4*)((float*)xout + o) = x0; *(f32x4*)((float*)xout + o + 4) = x1; }
                else { const f32x8_t ff = {x0.x, x0.y, x0.z, x0.w, x1.x, x1.y, x1.z, x1.w}; *(f16x8_t*)((bf16_t*)xout + o) = __builtin_convertvector(ff, f16x8_t); }
                ss += ((x0.x * x0.x + x0.y * x0.y) + (x0.z * x0.z + x0.w * x0.w)) + ((x1.x * x1.x + x1.y * x1.y) + (x1.z * x1.z + x1.w * x1.w));
                if (XS) *(u32x4*)(XS + xs_off(row0, col) + (ai * 128 + m * 16) * 64 + bj * (2 * 256 * 64)) = pack8(x0 * gs[bj][0], x1 * gs[bj][1]); }
            { const int ln = fr + 16 * fq; ss += bperm(ss, ln ^ 16); ss += bperm(ss, ln ^ 32); }
            if (fq == 0) RSS[(size_t)row * 32 + pn * 4 + wc] = ss; }
    }
    __device__ __forceinline__ void operator()(f32x4 (&acc)[2][2][4][2], const pg8::Unit& u, int ui, int wr, int wc, int fr, int fq) const {
        const int b = u.pm >> 4, row0 = u.pm * 256 + wr * 64 + fr, col = u.pn * 256 + wc * 32 + fq * 8;
        if (in_f32) {
#pragma unroll
            for (int ai = 0; ai < 2; ++ai) { half<true, 0, 2>(acc, ai, b, row0, col, u.pn, wc, fr, fq); half<true, 2, 4>(acc, ai, b, row0, col, u.pn, wc, fr, fq); } }
        else { half<false, 0, 4>(acc, 0, b, row0, col, u.pn, wc, fr, fq); half<false, 0, 4>(acc, 1, b, row0, col, u.pn, wc, fr, fq); }
    }
};
template <int CTRL> __device__ __forceinline__ float dpp_z(float v) { return __int_as_float(__builtin_amdgcn_update_dpp(0, __float_as_int(v), CTRL, 0xf, 0xf, false)); }
struct EpiUp {
    static constexpr bool PERM = true;
    const LAS float* RSTD; const float* SW; const float* cw; const float* cb; bf16_t* ACT; float* HA; float* HV;
    __device__ __forceinline__ void operator()(f32x4 (&acc)[2][2][4][2], const pg8::Unit& u, int ui, int wr, int wc, int fr, int fq) const {
        const int b = u.pm >> 4, lrow = wr * 128 + fr * 8, jc = u.pn * 128 + wc * 32 + fq * 8, swc = u.pn * 256 + wc * 32 + fq * 8;
        {   f32x4 swa[2], swv[2];
#pragma unroll
            for (int n = 0; n < 2; ++n) { swa[n] = *(const f32x4*)(SW + (size_t)b * NUP + swc + n * 4); swv[n] = *(const f32x4*)(SW + (size_t)b * NUP + swc + 128 + n * 4); }
#pragma unroll
            for (int ai = 0; ai < 2; ++ai)
#pragma unroll
                for (int m = 0; m < 4; ++m) { const float r = RSTD[ui * 256 + lrow + 4 * ai + m];
#pragma unroll
                    for (int n = 0; n < 2; ++n) { acc[ai][0][m][n] = acc[ai][0][m][n] * r + swa[n]; acc[ai][1][m][n] = acc[ai][1][m][n] * r + swv[n]; } }
        }
        {   const int kb = u.pm * 2 + wr;
            if (fr == 0) { float* pa = HA + ((size_t)kb * 4) * DFF + jc; float* pv = HV + ((size_t)kb * 2) * DFF + jc;
                *(f32x4*)pa = acc[0][0][0][0]; *(f32x4*)(pa + 4) = acc[0][0][0][1]; *(f32x4*)(pa + DFF) = acc[0][0][1][0]; *(f32x4*)(pa + DFF + 4) = acc[0][0][1][1];
                *(f32x4*)pv = acc[0][1][0][0]; *(f32x4*)(pv + 4) = acc[0][1][0][1]; *(f32x4*)(pv + DFF) = acc[0][1][1][0]; *(f32x4*)(pv + DFF + 4) = acc[0][1][1][1]; }
            if (fr == 15) { float* pa = HA + ((size_t)kb * 4 + 2) * DFF + jc;
                *(f32x4*)pa = acc[1][0][2][0]; *(f32x4*)(pa + 4) = acc[1][0][2][1]; *(f32x4*)(pa + DFF) = acc[1][0][3][0]; *(f32x4*)(pa + DFF + 4) = acc[1][0][3][1]; } }
#pragma unroll
        for (int n = 0; n < 2; ++n) {
            const f32x4 cbv = *(const f32x4*)(cb + jc + n * 4), w0 = *(const f32x4*)(cw + jc + n * 4), w1 = *(const f32x4*)(cw + DFF + jc + n * 4), w2 = *(const f32x4*)(cw + 2 * DFF + jc + n * 4);
            f32x4 p2, p1;
            { const f32x4 x6 = acc[1][0][2][n], x7 = acc[1][0][3][n];
              p2 = (f32x4){dpp_z<0x111>(x6.x), dpp_z<0x111>(x6.y), dpp_z<0x111>(x6.z), dpp_z<0x111>(x6.w)};
              p1 = (f32x4){dpp_z<0x111>(x7.x), dpp_z<0x111>(x7.y), dpp_z<0x111>(x7.z), dpp_z<0x111>(x7.w)}; }
#pragma unroll
            for (int j = 0; j < 8; ++j) { const f32x4 x = acc[j >> 2][0][j & 3][n];
                const f32x4 cv = cbv + w0 * p2 + w1 * p1 + w2 * x;
                acc[j >> 2][1][j & 3][n] = silu4(cv) * acc[j >> 2][1][j & 3][n];
                p2 = p1; p1 = x; }
        }
#pragma unroll
        for (int j = 0; j < 8; ++j) *(u32x4*)(ACT + (size_t)u.pm * (256 * DFF) + (size_t)(jc >> 6) * (256 * 64) + (lrow + j) * 64 + (jc & 63)) = pack8(acc[j >> 2][1][j & 3][0], acc[j >> 2][1][j & 3][1]);
    }
};

constexpr int NTHR_C = 512;
typedef short s16x4 __attribute__((ext_vector_type(4)));
__device__ __forceinline__ unsigned vl_off(unsigned row, unsigned ch) { return 256u * row + 16u * (ch ^ (((row & 3u) << 2) | ((row >> 2) & 3u))); }
__device__ __forceinline__ s16x4 vl_tr_read(LAS unsigned char* vl, int R, int c, int lane) {
    const unsigned q = ((unsigned)lane & 15u) >> 2, p = (unsigned)lane & 3u;
    return __builtin_amdgcn_ds_read_tr16_b64_v4i16((LAS s16x4*)(vl + vl_off((unsigned)R + q, 2u * (unsigned)c + (p >> 1)) + 8u * (p & 1u)));
}
__device__ __forceinline__ void load_lf(const float* LFc, int w, int fr, int fq, float (&lf)[2][8]) {
    const float* p = LFc + 16 * w + fr;
#pragma unroll
    for (int ks = 0; ks < 2; ++ks)
#pragma unroll
        for (int i = 0; i < 8; ++i) lf[ks][i] = p[(size_t)(32 * ks + 8 * fq + i) * DH];
}
__device__ __forceinline__ void cumsum_from(const float (&lf)[2][8], int fr, int fq, float (&b)[2][8], float& blast) {
#pragma unroll
    for (int ks = 0; ks < 2; ++ks) { b[ks][0] = lf[ks][0];
#pragma unroll
        for (int i = 1; i < 8; ++i) b[ks][i] = b[ks][i - 1] + lf[ks][i]; }
    const float T0 = b[0][7], T1 = b[1][7]; float x0 = T0, x1 = T1, y;
    const int ln = fr + 16 * fq;
    y = bperm(x0, (ln - 16) & 63); if (fq >= 1) x0 += y;
    y = bperm(x0, (ln - 32) & 63); if (fq >= 2) x0 += y;
    y = bperm(x1, (ln - 16) & 63); if (fq >= 1) x1 += y;
    y = bperm(x1, (ln - 32) & 63); if (fq >= 2) x1 += y;
    const float tot0 = bperm(x0, fr + 48), tot1 = bperm(x1, fr + 48);
    const float off0 = x0 - T0, off1 = tot0 + x1 - T1;
#pragma unroll
    for (int i = 0; i < 8; ++i) { b[0][i] += off0; b[1][i] += off1; }
    blast = tot0 + tot1;
}
__device__ __forceinline__ void load_v_regs(const bf16_t* Vc, int tid, u32x4 (&vr)[2]) {
#pragma unroll
    for (int j = 0; j < 2; ++j) { const int c = tid + 512 * j, row = c >> 4, ch = c & 15; vr[j] = *(const u32x4*)(Vc + (size_t)row * DH + ch * 8); }
}
__device__ __forceinline__ void store_v_image(LAS unsigned char* vl, int tid, const u32x4 (&vr)[2]) {
#pragma unroll
    for (int j = 0; j < 2; ++j) { const int c = tid + 512 * j, row = c >> 4, ch = c & 15; *(LAS u32x4*)(vl + vl_off(row, ch)) = vr[j]; }
}
constexpr int H_BM = 0, H_KB = 33792, H_VL = 51200;

__device__ __forceinline__ void unpack8(const u32x4 r, float (&o)[8]) { o[0] = __uint_as_float(r.x << 16); o[1] = __uint_as_float(r.x & 0xffff0000u); o[2] = __uint_as_float(r.y << 16); o[3] = __uint_as_float(r.y & 0xffff0000u);
    o[4] = __uint_as_float(r.z << 16); o[5] = __uint_as_float(r.z & 0xffff0000u); o[6] = __uint_as_float(r.w << 16); o[7] = __uint_as_float(r.w & 0xffff0000u); }
__device__ __forceinline__ bf16x8 pack8f(const float (&v)[8]) { u32x4 pk; pk.x = cvt_pk_bf16_c(v[0], v[1]); pk.y = cvt_pk_bf16_c(v[2], v[3]); pk.z = cvt_pk_bf16_c(v[4], v[5]); pk.w = cvt_pk_bf16_c(v[6], v[7]); return __builtin_bit_cast(bf16x8, pk); }
template <class Ord> __device__ __forceinline__ void hgrn_h1(LAS unsigned char* lds, const _Float16* LF, const bf16_t* V, bf16_t* DS, float* DEC, const Ord& O, int tid) {
    const int w = __builtin_amdgcn_readfirstlane(tid >> 6), lane0 = tid & 63, grp = w >> 2, wl = w & 3;
    LAS unsigned char* gb = lds + grp * 50176;
    LAS float* LS = (LAS float*)gb; LAS unsigned char* vl = gb + 33792;
    f16x8_t lc[4]; u32x4 vr[4];
    int item = O.item(grp);
    if (item >= 0) { const int tg = wl * 64 + lane0; const int bh = item >> 6, n = item & 63; const size_t row0 = (size_t)(bh >> 3) * SEQ + (size_t)n * CH;
        const _Float16* lfc = LF + row0 * DH + (bh & 7) * 128; const bf16_t* vc = V + row0 * DH + (bh & 7) * 128;
#pragma unroll
        for (int j = 0; j < 4; ++j) { const int c = tg + 256 * j; lc[j] = *(const f16x8_t*)(lfc + (size_t)(c >> 4) * DH + (c & 15) * 8); vr[j] = *(const u32x4*)(vc + (size_t)(c >> 4) * DH + (c & 15) * 8); } }
    for (int k = 0; O.item(k) >= 0; k += 2) {
        const int nx = O.item(k + 2 + grp);
        int lane = lane0; asm volatile("" : "+v"(lane));
        const int fr = lane & 15, fq = lane >> 4, tg = wl * 64 + lane;
        if (item >= 0) {
#pragma unroll
            for (int j = 0; j < 4; ++j) { const int c = tg + 256 * j; const f32x8_t ff = __builtin_convertvector(lc[j], f32x8_t); LAS float* d = LS + (c >> 4) * 132 + (c & 15) * 8;
                *(LAS f32x4*)d = (f32x4){ff[0], ff[1], ff[2], ff[3]}; *(LAS f32x4*)(d + 4) = (f32x4){ff[4], ff[5], ff[6], ff[7]};
                *(LAS u32x4*)(vl + vl_off(c >> 4, c & 15)) = vr[j]; }
        }
        asm volatile("s_waitcnt lgkmcnt(0)" ::: "memory"); __syncthreads();
        if (nx >= 0) {
            const int bh = nx >> 6, n = nx & 63; const size_t row0 = (size_t)(bh >> 3) * SEQ + (size_t)n * CH; const _Float16* lfc = LF + row0 * DH + (bh & 7) * 128; const bf16_t* vc = V + row0 * DH + (bh & 7) * 128;
#pragma unroll
            for (int j = 0; j < 4; ++j) { const int c = tg + 256 * j; lc[j] = *(const f16x8_t*)(lfc + (size_t)(c >> 4) * DH + (c & 15) * 8); vr[j] = *(const u32x4*)(vc + (size_t)(c >> 4) * DH + (c & 15) * 8); } }
        if (item >= 0) {
            bf16x8 kf[2][2]; float bl[2];
#pragma unroll
            for (int ps = 0; ps < 2; ++ps) { float lf[2][8], b[2][8]; const int d = 16 * (2 * wl + ps) + fr;
#pragma unroll
                for (int ks = 0; ks < 2; ++ks)
#pragma unroll
                    for (int i = 0; i < 8; ++i) lf[ks][i] = LS[(32 * ks + 8 * fq + i) * 132 + d];
                cumsum_from(lf, fr, fq, b, bl[ps]);
#pragma unroll
                for (int ks = 0; ks < 2; ++ks) { float kv[8];
#pragma unroll
                    for (int i = 0; i < 8; ++i) kv[i] = (1.f - __expf(lf[ks][i])) * __expf(bl[ps] - b[ks][i]);
                    kf[ps][ks] = pack8f(kv); } }
            bf16_t* dsp = DS + (size_t)item * (HD * HD);
#pragma unroll
            for (int c = 0; c < 8; ++c) { f32x4 acc0 = (f32x4){0.f, 0.f, 0.f, 0.f}, acc1 = (f32x4){0.f, 0.f, 0.f, 0.f};
#pragma unroll
                for (int ks = 0; ks < 2; ++ks) { const s16x4 lo = vl_tr_read(vl, 32 * ks + 8 * fq, c, lane), hi = vl_tr_read(vl, 32 * ks + 8 * fq + 4, c, lane);
                    const bf16x8 vf = __builtin_shufflevector(lo, hi, 0, 1, 2, 3, 4, 5, 6, 7);
                    acc0 = __builtin_amdgcn_mfma_f32_16x16x32_bf16(kf[0][ks], vf, acc0, 0, 0, 0);
                    acc1 = __builtin_amdgcn_mfma_f32_16x16x32_bf16(kf[1][ks], vf, acc1, 0, 0, 0); }
                u32x2 o0, o1; o0.x = cvt_pk_bf16_c(acc0.x, acc0.y); o0.y = cvt_pk_bf16_c(acc0.z, acc0.w); o1.x = cvt_pk_bf16_c(acc1.x, acc1.y); o1.y = cvt_pk_bf16_c(acc1.z, acc1.w);
                const auto r0 = __builtin_amdgcn_permlane16_swap(o0.x, o1.x, false, false); const auto r1 = __builtin_amdgcn_permlane16_swap(o0.y, o1.y, false, false);
                u32x4 wv; wv.x = r0[0]; wv.y = r1[0]; wv.z = r0[1]; wv.w = r1[1];
                *(u32x4*)(dsp + (size_t)(16 * c + fr) * HD + 32 * wl + ((fq & 1) ? 16 + 4 * (fq - 1) : 4 * fq)) = wv; }
            if (fq == 0) { DEC[(size_t)item * HD + 32 * wl + fr] = __expf(bl[0]); DEC[(size_t)item * HD + 32 * wl + 16 + fr] = __expf(bl[1]); }
        }
        asm volatile("s_waitcnt lgkmcnt(0)" ::: "memory"); __syncthreads();
        item = nx;
    }
}
__device__ __forceinline__ void acc8(float (&s)[8], const u32x4 r, float sg) {
    s[0] += sg * __uint_as_float(r.x << 16); s[1] += sg * __uint_as_float(r.x & 0xffff0000u); s[2] += sg * __uint_as_float(r.y << 16); s[3] += sg * __uint_as_float(r.y & 0xffff0000u);
    s[4] += sg * __uint_as_float(r.z << 16); s[5] += sg * __uint_as_float(r.z & 0xffff0000u); s[6] += sg * __uint_as_float(r.w << 16); s[7] += sg * __uint_as_float(r.w & 0xffff0000u); }
template <int W> __device__ __forceinline__ void pool_item(const bf16_t* up, bf16_t* pp, int ldo, int t0) {
    u32x4 pv[W], ur[16];
    if (t0 > 0) {
#pragma unroll
        for (int k = 0; k < W; ++k) pv[k] = *(const u32x4*)(up + (ptrdiff_t)(k - W) * DP); }
#pragma unroll
    for (int i = 0; i < 16; ++i) ur[i] = *(const u32x4*)(up + (size_t)i * DP);
    float sum[8];
#pragma unroll
    for (int j = 0; j < 8; ++j) sum[j] = 0.f;
    if (t0 > 0) {
#pragma unroll
        for (int k = 0; k < W; ++k) acc8(sum, pv[k], 1.f); }
#pragma unroll
    for (int i = 0; i < 16; ++i) { float u[8]; unpack8(ur[i], u);
#pragma unroll
        for (int j = 0; j < 8; ++j) sum[j] += u[j];
        if (i >= W) acc8(sum, ur[i >= W ? i - W : 0], -1.f); else if (t0 > 0) acc8(sum, pv[i < W ? i : 0], -1.f);
        const float inv = (t0 > 0 || i + 1 >= W) ? 1.f / (float)W : 1.f / (float)(i + 1);
        u32x4 o; o.x = cvt_pk_bf16_c(sum[0] * inv - u[0], sum[1] * inv - u[1]); o.y = cvt_pk_bf16_c(sum[2] * inv - u[2], sum[3] * inv - u[3]);
        o.z = cvt_pk_bf16_c(sum[4] * inv - u[4], sum[5] * inv - u[5]); o.w = cvt_pk_bf16_c(sum[6] * inv - u[6], sum[7] * inv - u[7]);
        *(u32x4*)(pp + (size_t)i * ldo) = o; }
}
__device__ __forceinline__ void pool_elem(const bf16_t* U, bf16_t* PO, int ldo, int cid, int G, int tid) {
    if (tid < 256) return;
    const bool team = (G == 256);
    const int vidq = 32 * (cid & 7) + (cid >> 3), pmq = vidq >> 2, pq = vidq & 3;
    const int pw = team ? ((tid - 256) >> 6) : cid * 4 + ((tid - 256) >> 6), lane = tid & 63;
    for (int wi = pw; wi < (team ? 8 : (M / 32) * 4); wi += (team ? 4 : G * 4)) {
        const int g = __builtin_amdgcn_readfirstlane(team ? pq : (wi & 3)), rp = team ? 8 * pmq + wi : (wi >> 2), r16 = 2 * rp + (lane >> 5), oct = 32 * g + (lane & 31); const int row0 = 16 * r16, t0 = row0 % SEQ;
        const bf16_t* up = U + (size_t)row0 * DP + oct * 8; bf16_t* pp = PO + xs_off(row0, DH + oct * 8);
        if (g == 0) pool_item<2>(up, pp, ldo, t0); else if (g == 1) pool_item<4>(up, pp, ldo, t0); else if (g == 2) pool_item<8>(up, pp, ldo, t0); else pool_item<16>(up, pp, ldo, t0);
    }
}
__device__ __forceinline__ void hgrn_h2(LAS unsigned char* lds, bf16_t* DS, const float* DEC, int cid, int G, int tid) {
    if (tid < 256) { const int lane = tid & 63; LAS float* DL = (LAS float*)(lds + (tid >> 6) * 32768);
      const bool team = (G == 256); const int vidq = 32 * (cid & 7) + (cid >> 3), pmq = vidq >> 2, pq = vidq & 3;
      const int g0 = team ? (((pmq >> 4) * 8 + 2 * pq) << 11) + 256 * (pmq & 15) + tid : cid * 256 + tid;
      for (int g = g0; g < NB * NH * HD * (HD / 8); g += (team ? NB * NH * HD * (HD / 8) : G * 256)) {
        const int bh = g >> 11, v = (g >> 4) & 127, d = (g & 15) * 8;
        bf16_t* p = DS + (size_t)bh * NCH * (HD * HD) + (size_t)v * HD + d; const float* dp = DEC + (size_t)bh * NCH * HD;
        float S[8];
#pragma unroll
        for (int j = 0; j < 8; ++j) S[j] = 0.f;
        u32x4 raw[16];
#pragma unroll
        for (int j = 0; j < 16; ++j) raw[j] = *(const u32x4*)(p + (size_t)j * (HD * HD));
        asm volatile("s_waitcnt lgkmcnt(0)" ::: "memory");
#pragma unroll
        for (int h = 0; h < 4; ++h) { f32x4 t[8];
#pragma unroll
            for (int j = 0; j < 8; ++j) t[j] = *(const f32x4*)(dp + 4 * (lane + 64 * (8 * h + j)));
#pragma unroll
            for (int j = 0; j < 8; ++j) *(LAS f32x4*)(DL + 4 * (lane + 64 * (8 * h + j))) = t[j]; }
        asm volatile("s_waitcnt lgkmcnt(0)" ::: "memory");
#pragma unroll 1
        for (int n0 = 0; n0 < NCH; n0 += 16) {
#pragma unroll
            for (int j = 0; j < 16; ++j) { u32x4 o; o.x = cvt_pk_bf16_c(S[0], S[1]); o.y = cvt_pk_bf16_c(S[2], S[3]); o.z = cvt_pk_bf16_c(S[4], S[5]); o.w = cvt_pk_bf16_c(S[6], S[7]);
                float t[8]; unpack8(raw[j], t);
                if (n0 + 16 < NCH) raw[j] = *(const u32x4*)(p + (size_t)(n0 + 16 + j) * (HD * HD));
                *(u32x4*)(p + (size_t)(n0 + j) * (HD * HD)) = o;
                const f32x4 dc0 = *(const LAS f32x4*)(DL + (n0 + j) * HD + d), dc1 = *(const LAS f32x4*)(DL + (n0 + j) * HD + d + 4);
                S[0] = dc0.x * S[0] + t[0]; S[1] = dc0.y * S[1] + t[1]; S[2] = dc0.z * S[2] + t[2]; S[3] = dc0.w * S[3] + t[3];
                S[4] = dc1.x * S[4] + t[4]; S[5] = dc1.y * S[5] + t[5]; S[6] = dc1.z * S[6] + t[6]; S[7] = dc1.w * S[7] + t[7]; } }
      } }
}

constexpr int H3_ITEM_LDS = 67584;
__device__ __forceinline__ int h3_item(int cid, int G, int grp, int p) {
    if (G == 256) { if (p >= 4) return NB * NH * NCH; const int vidq = 32 * (cid & 7) + (cid >> 3), pm = vidq >> 2, pq = vidq & 3, k = 2 * p + grp;
        return ((((pm >> 4) * 8 + 2 * pq + (k >> 2)) << 6) + (pm & 15) * 4 + (k & 3)); }
    return cid + grp * G + 2 * G * p;
}
__device__ __forceinline__ void hgrn_h3(LAS unsigned char* lds, const bf16_t* Q, const _Float16* LF, const bf16_t* V, const bf16_t* SG, const bf16_t* SP, const float* gn, bf16_t* YAB, int cid, int G, int tid) {
    const int w = __builtin_amdgcn_readfirstlane(tid >> 6), lane0 = tid & 63, grp = w >> 2, wl = w & 3, tt = grp ? 3 - wl : wl;
    LAS unsigned char* gb = lds + grp * H3_ITEM_LDS;
    LAS float* BM = (LAS float*)(gb + H_BM); LAS unsigned char* KB = gb + H_KB; LAS unsigned char* vl = gb + H_VL;
    f16x8_t lc[4]; u32x4 vr[4];
    int item = h3_item(cid, G, grp, 0);
    if (item < NB * NH * NCH) { const int tg = wl * 64 + lane0; const int bh = item >> 6, n = item & 63; const size_t row0 = (size_t)(bh >> 3) * SEQ + (size_t)n * CH; const _Float16* lfc = LF + row0 * DH + (bh & 7) * 128; const bf16_t* vc = V + row0 * DH + (bh & 7) * 128;
#pragma unroll
        for (int j = 0; j < 4; ++j) { const int c = tg + 256 * j; lc[j] = *(const f16x8_t*)(lfc + (size_t)(c >> 4) * DH + (c & 15) * 8); vr[j] = *(const u32x4*)(vc + (size_t)(c >> 4) * DH + (c & 15) * 8); } }
    for (int p = 0; h3_item(cid, G, 0, p) < NB * NH * NCH; ++p, item = h3_item(cid, G, grp, p)) {
        const bool act = item < NB * NH * NCH;
        int lane = lane0; asm volatile("" : "+v"(lane));
        const int fr = lane & 15, fq = lane >> 4, tg = wl * 64 + lane;
        const int bh = item >> 6, n = item & 63, b_ = bh >> 3, h = bh & 7; const size_t row0 = (size_t)b_ * SEQ + (size_t)n * CH;
        const size_t grow = row0 + 16 * tt + fr;
        const bf16_t* spp = SP + (size_t)item * (HD * HD);
        bf16x8 sf[3][8]; u32x4 qr[4];
        if (act) {
#pragma unroll
            for (int kd = 0; kd < 2; ++kd)
#pragma unroll
                for (int vt = 0; vt < 8; ++vt) sf[kd][vt] = *(const bf16x8*)(spp + (size_t)(16 * vt + fr) * HD + 32 * kd + 8 * fq);
#pragma unroll
            for (int kd = 0; kd < 4; ++kd) qr[kd] = *(const u32x4*)(Q + grow * DH + h * 128 + 32 * kd + 8 * fq);
        }
        if (act) {
#pragma unroll
            for (int j = 0; j < 4; ++j) { const int c = tg + 256 * j; const f32x8_t ff = __builtin_convertvector(lc[j], f32x8_t); LAS float* d = BM + (c >> 4) * 132 + (c & 15) * 8;
                *(LAS f32x4*)d = (f32x4){ff[0], ff[1], ff[2], ff[3]}; *(LAS f32x4*)(d + 4) = (f32x4){ff[4], ff[5], ff[6], ff[7]};
                *(LAS u32x4*)(vl + vl_off(c >> 4, c & 15)) = vr[j]; }
        }
        asm volatile("s_waitcnt lgkmcnt(0)" ::: "memory"); __syncthreads();
        if (act) {
#pragma unroll
            for (int ps = 0; ps < 2; ++ps) { float lf[2][8], b[2][8], blast; const int d = 16 * (2 * wl + ps) + fr; unsigned kpk[2][8];
#pragma unroll
                for (int ks = 0; ks < 2; ++ks)
#pragma unroll
                    for (int i = 0; i < 8; ++i) lf[ks][i] = BM[(32 * ks + 8 * fq + i) * 132 + d];
                cumsum_from(lf, fr, fq, b, blast);
#pragma unroll
                for (int ks = 0; ks < 2; ++ks) { const float rend = bperm(b[ks][7], fr + 16 * (fq | 1));
#pragma unroll
                    for (int i = 0; i < 8; ++i) { const int s_ = 32 * ks + 8 * fq + i; BM[s_ * 132 + d] = b[ks][i];
                        const float kv = (1.f - __expf(lf[ks][i])) * __expf(rend - b[ks][i]);
                        const float ko = __int_as_float(__builtin_amdgcn_update_dpp(0, __float_as_int(kv), 0xB1, 0xf, 0xf, true));
                        kpk[ks][i] = cvt_pk_bf16_c(kv, ko); } }
                if ((fr & 1) == 0) {
#pragma unroll
                    for (int ks = 0; ks < 2; ++ks)
#pragma unroll
                        for (int i = 0; i < 8; ++i) *(LAS unsigned*)(KB + ((32 * ks + 8 * fq + i) * 136 + d) * 2) = kpk[ks][i]; } }
        }
        asm volatile("s_waitcnt lgkmcnt(0)" ::: "memory"); __syncthreads();
        {   const int nx = h3_item(cid, G, grp, p + 1);
            if (nx < NB * NH * NCH) { const int bh2 = nx >> 6, n2 = nx & 63; const size_t r2 = (size_t)(bh2 >> 3) * SEQ + (size_t)n2 * CH; const _Float16* lfc = LF + r2 * DH + (bh2 & 7) * 128; const bf16_t* vc = V + r2 * DH + (bh2 & 7) * 128;
#pragma unroll
                for (int j = 0; j < 4; ++j) { const int c = tg + 256 * j; lc[j] = *(const f16x8_t*)(lfc + (size_t)(c >> 4) * DH + (c & 15) * 8); }
                (void)vc; } }
        if (act) {
            f32x4 acc[8], pt[4];
#pragma unroll
            for (int vt = 0; vt < 8; ++vt) sf[2][vt] = *(const bf16x8*)(spp + (size_t)(16 * vt + fr) * HD + 32 * 2 + 8 * fq);
            const int vsw = (fq & 1) ? 16 + 4 * (fq - 1) : 4 * fq;
            u32x4 sgw[4];
#pragma unroll
            for (int vt = 0; vt < 8; ++vt) acc[vt] = (f32x4){0.f, 0.f, 0.f, 0.f};
#pragma unroll
            for (int st = 0; st < 4; ++st) pt[st] = (f32x4){0.f, 0.f, 0.f, 0.f};
#pragma unroll
            for (int kd = 0; kd < 4; ++kd) {
                float q8[8], bt[8]; unpack8(qr[kd], q8);
                { const f32x4 b0 = *(const LAS f32x4*)(BM + (16 * tt + fr) * 132 + 32 * kd + 8 * fq), b1 = *(const LAS f32x4*)(BM + (16 * tt + fr) * 132 + 32 * kd + 8 * fq + 4);
                  bt[0] = b0.x; bt[1] = b0.y; bt[2] = b0.z; bt[3] = b0.w; bt[4] = b1.x; bt[5] = b1.y; bt[6] = b1.z; bt[7] = b1.w; }
#pragma unroll
                for (int st = 0; st < 4; ++st) if (st <= tt) {
                    const f32x4 r0 = *(const LAS f32x4*)(BM + (16 * st + 15) * 132 + 32 * kd + 8 * fq), r1 = *(const LAS f32x4*)(BM + (16 * st + 15) * 132 + 32 * kd + 8 * fq + 4);
                    float e[8]; e[0] = q8[0] * __expf(bt[0] - r0.x); e[1] = q8[1] * __expf(bt[1] - r0.y); e[2] = q8[2] * __expf(bt[2] - r0.z); e[3] = q8[3] * __expf(bt[3] - r0.w);
                    e[4] = q8[4] * __expf(bt[4] - r1.x); e[5] = q8[5] * __expf(bt[5] - r1.y); e[6] = q8[6] * __expf(bt[6] - r1.z); e[7] = q8[7] * __expf(bt[7] - r1.w);
                    const bf16x8 qf = pack8f(e);
                    const bf16x8 kf = *(const LAS bf16x8*)(KB + ((16 * st + fr) * 136 + 32 * kd + 8 * fq) * 2);
                    pt[st] = __builtin_amdgcn_mfma_f32_16x16x32_bf16(kf, qf, pt[st], 0, 0, 0); }
                { float e[8];
#pragma unroll
                  for (int j = 0; j < 8; ++j) e[j] = q8[j] * __expf(bt[j]);
                  const bf16x8 qb = pack8f(e);
#pragma unroll
                  for (int vt = 0; vt < 8; ++vt) acc[vt] = __builtin_amdgcn_mfma_f32_16x16x32_bf16(sf[kd % 3][vt], qb, acc[vt], 0, 0, 0); }
                if (kd == 0) {
#pragma unroll
                    for (int vt = 0; vt < 8; ++vt) sf[0][vt] = *(const bf16x8*)(spp + (size_t)(16 * vt + fr) * HD + 32 * 3 + 8 * fq); }
                if (kd == 2) {
#pragma unroll
                    for (int j = 0; j < 4; ++j) sgw[j] = *(const u32x4*)(SG + grow * DH + h * 128 + 32 * j + vsw); }
            }
            {   const int nx = h3_item(cid, G, grp, p + 1);
                if (nx < NB * NH * NCH) { const int bh2 = nx >> 6, n2 = nx & 63; const size_t r2 = (size_t)(bh2 >> 3) * SEQ + (size_t)n2 * CH; const bf16_t* vc = V + r2 * DH + (bh2 & 7) * 128;
#pragma unroll
                    for (int j = 0; j < 4; ++j) { const int c = tg + 256 * j; vr[j] = *(const u32x4*)(vc + (size_t)(c >> 4) * DH + (c & 15) * 8); } } }
            u32x2 ppk[4];
#pragma unroll
            for (int st = 0; st < 4; ++st) { f32x4 p = pt[st]; const int sl = 16 * st + 4 * fq, tl = 16 * tt + fr;
                if (sl + 0 > tl) p.x = 0.f; if (sl + 1 > tl) p.y = 0.f; if (sl + 2 > tl) p.z = 0.f; if (sl + 3 > tl) p.w = 0.f;
                ppk[st].x = cvt_pk_bf16_c(p.x, p.y); ppk[st].y = cvt_pk_bf16_c(p.z, p.w); }
#pragma unroll
            for (int kp = 0; kp < 2; ++kp) if (2 * kp <= tt) { u32x4 pw; pw.x = ppk[2 * kp].x; pw.y = ppk[2 * kp].y; pw.z = ppk[2 * kp + 1].x; pw.w = ppk[2 * kp + 1].y; const bf16x8 pf = __builtin_bit_cast(bf16x8, pw);
#pragma unroll
                for (int vt = 0; vt < 8; ++vt) { const s16x4 lo = vl_tr_read(vl, 32 * kp + 4 * fq, vt, lane), hi = vl_tr_read(vl, 32 * kp + 16 + 4 * fq, vt, lane);
                    const bf16x8 vf = __builtin_shufflevector(lo, hi, 0, 1, 2, 3, 4, 5, 6, 7);
                    acc[vt] = __builtin_amdgcn_mfma_f32_16x16x32_bf16(vf, pf, acc[vt], 0, 0, 0); } }
            float ss = 0.f;
#pragma unroll
            for (int vt = 0; vt < 8; ++vt) ss += (acc[vt].x * acc[vt].x + acc[vt].y * acc[vt].y) + (acc[vt].z * acc[vt].z + acc[vt].w * acc[vt].w);
            ss += bperm(ss, lane ^ 16); ss += bperm(ss, lane ^ 32);
            const float rstd = rsqrtf(ss * (1.f / 128.f) + EPS);
#pragma unroll
            for (int j = 0; j < 4; ++j) {
                const auto g0 = __builtin_amdgcn_permlane16_swap(sgw[j].x, sgw[j].z, false, false); const auto g1 = __builtin_amdgcn_permlane16_swap(sgw[j].y, sgw[j].w, false, false);
                u32x2 sg2[2]; sg2[0].x = g0[0]; sg2[0].y = g1[0]; sg2[1].x = g0[1]; sg2[1].y = g1[1];
                u32x2 o2[2];
#pragma unroll
                for (int q = 0; q < 2; ++q) { const int vt = 2 * j + q, vc = 16 * vt + 4 * fq; const f32x4 g4 = *(const f32x4*)(gn + vc);
                    const float s0 = __uint_as_float(sg2[q].x << 16), s1 = __uint_as_float(sg2[q].x & 0xffff0000u), s2 = __uint_as_float(sg2[q].y << 16), s3 = __uint_as_float(sg2[q].y & 0xffff0000u);
                    o2[q].x = cvt_pk_bf16_c(acc[vt].x * rstd * g4.x * s0, acc[vt].y * rstd * g4.y * s1); o2[q].y = cvt_pk_bf16_c(acc[vt].z * rstd * g4.z * s2, acc[vt].w * rstd * g4.w * s3); }
                const auto r0 = __builtin_amdgcn_permlane16_swap(o2[0].x, o2[1].x, false, false); const auto r1 = __builtin_amdgcn_permlane16_swap(o2[0].y, o2[1].y, false, false);
                u32x4 wv; wv.x = r0[0]; wv.y = r1[0]; wv.z = r0[1]; wv.w = r1[1];
                *(u32x4*)(YAB + xs_off((int)grow, h * 128 + 32 * j + vsw)) = wv; }
        }
        asm volatile("s_waitcnt lgkmcnt(0)" ::: "memory"); __syncthreads();
    }
}

__device__ __forceinline__ void wt_item(const float* W, int K, int N, bf16_t* WT, bool upmap, LAS float* scr, int item, int lane) {
    const int nblk = N / 32, kb = item / nblk, nb = item % nblk, k0 = 64 * kb, n0 = 32 * nb;
    {   f32x4 t[8];
#pragma unroll
        for (int i = 0; i < 8; ++i) t[i] = *(const f32x4*)(W + (size_t)(k0 + (lane >> 3) + 8 * i) * N + n0 + 4 * (lane & 7));
#pragma unroll
        for (int i = 0; i < 8; ++i) { LAS float* d = scr + ((lane >> 3) + 8 * i) * 33 + 4 * (lane & 7); d[0] = t[i].x; d[1] = t[i].y; d[2] = t[i].z; d[3] = t[i].w; } }
    asm volatile("s_waitcnt lgkmcnt(0)" ::: "memory");
    const int c = lane & 7, r0 = upmap ? up_rowmap(n0) : n0;
#pragma unroll
    for (int j = 0; j < 4; ++j) { const int n = (lane >> 3) + 8 * j; const LAS float* sp = scr + (8 * c) * 33 + n;
        u32x4 o; o.x = cvt_pk_bf16_c(sp[0 * 33], sp[1 * 33]); o.y = cvt_pk_bf16_c(sp[2 * 33], sp[3 * 33]); o.z = cvt_pk_bf16_c(sp[4 * 33], sp[5 * 33]); o.w = cvt_pk_bf16_c(sp[6 * 33], sp[7 * 33]);
        *(u32x4*)(WT + (size_t)(r0 + n) * K + k0 + 8 * c) = o; }
    asm volatile("s_waitcnt lgkmcnt(0)" ::: "memory");
}
template <bool WITH_SW, bool TILED = false> __device__ __forceinline__ void wt_col_item(const float* W, int N, bf16_t* WT, int Kst, int kb0, int kb1, bool upmap, LAS float* scr, int nb, int lane, const float* shift, float* SWo) {
    const int n0 = 32 * nb, c = lane & 7, r0 = upmap ? up_rowmap(n0) : n0;
    f32x4 t[8];
#pragma unroll
    for (int i = 0; i < 8; ++i) t[i] = *(const f32x4*)(W + (size_t)(64 * kb0 + (lane >> 3) + 8 * i) * N + n0 + 4 * (lane & 7));
    float a[4][NB];
#pragma unroll
    for (int j = 0; j < 4; ++j)
#pragma unroll
        for (int b = 0; b < NB; ++b) a[j][b] = 0.f;
    for (int kb = kb0; kb < kb1; ++kb) { const int k0 = 64 * kb;
#pragma unroll
        for (int i = 0; i < 8; ++i) { LAS float* d = scr + ((lane >> 3) + 8 * i) * 33 + 4 * (lane & 7); d[0] = t[i].x; d[1] = t[i].y; d[2] = t[i].z; d[3] = t[i].w; }
        if (kb + 1 < kb1) {
#pragma unroll
            for (int i = 0; i < 8; ++i) t[i] = *(const f32x4*)(W + (size_t)(k0 + 64 + (lane >> 3) + 8 * i) * N + n0 + 4 * (lane & 7)); }
        f32x4 s0[NB], s1[NB];
        if constexpr (WITH_SW) {
#pragma unroll
            for (int b = 0; b < NB; ++b) { s0[b] = *(const f32x4*)(shift + (size_t)b * 6 * D + k0 + 8 * c); s1[b] = *(const f32x4*)(shift + (size_t)b * 6 * D + k0 + 8 * c + 4); } }
        asm volatile("s_waitcnt lgkmcnt(0)" ::: "memory");
#pragma unroll
        for (int j = 0; j < 4; ++j) { const int n = (lane >> 3) + 8 * j; const LAS float* sp = scr + (8 * c) * 33 + n;
            u32x4 o; o.x = cvt_pk_bf16_c(sp[0 * 33], sp[1 * 33]); o.y = cvt_pk_bf16_c(sp[2 * 33], sp[3 * 33]); o.z = cvt_pk_bf16_c(sp[4 * 33], sp[5 * 33]); o.w = cvt_pk_bf16_c(sp[6 * 33], sp[7 * 33]);
            if constexpr (TILED) *(u32x4*)(WT + (size_t)((r0 + n) >> 8) * ((size_t)256 * Kst) + (size_t)(k0 >> 6) * (256 * 64) + ((r0 + n) & 255) * 64 + 8 * c) = o;
            else *(u32x4*)(WT + (size_t)(r0 + n) * Kst + k0 + 8 * c) = o;
            if constexpr (WITH_SW) { float wv[8]; unpack8(o, wv);
#pragma unroll
                for (int b = 0; b < NB; ++b) a[j][b] += (s0[b].x * wv[0] + s0[b].y * wv[1]) + (s0[b].z * wv[2] + s0[b].w * wv[3]) + (s1[b].x * wv[4] + s1[b].y * wv[5]) + (s1[b].z * wv[6] + s1[b].w * wv[7]); } }
        asm volatile("s_waitcnt lgkmcnt(0)" ::: "memory");
    }
    if constexpr (WITH_SW) {
#pragma unroll
        for (int j = 0; j < 4; ++j)
#pragma unroll
            for (int b = 0; b < NB; ++b) { float v = a[j][b]; v += bperm(v, lane ^ 1); v += bperm(v, lane ^ 2); v += bperm(v, lane ^ 4);
                if (c == 0) SWo[(size_t)b * N + r0 + (lane >> 3) + 8 * j] = v; } }
}
constexpr int WT_I_IN = (D / 64) * (DIN / 32), WT_I_OUT = (D / 64) * (D / 32), WT_I_UP = (D / 64) * (NUP / 32), WT_I_DN = (DFF / 64) * (D / 32), WT_I_PL = (256 / 64) * (256 / 32);
constexpr int WT_ITEMS = L * (WT_I_OUT + WT_I_DN);
constexpr int MOD_KC = 32;
__device__ __forceinline__ void pro_a(LAS unsigned char* lds, const float* const* in, unsigned char* wsl, int cid, int G, int tid) {
    const int wave = __builtin_amdgcn_readfirstlane(tid >> 6), lane = tid & 63;
    {   LAS float* ca = (LAS float*)lds;
        for (int item = cid; item < L * MOD_KC * 2; item += G) {
            const int l = item / (MOD_KC * 2), kc = (item / 2) % MOD_KC, nh = item & 1;
            __syncthreads();
            if (tid < 256) { const int k = tid >> 2, b = tid & 3; ca[tid] = siluf(in[1][(size_t)b * D + kc * 64 + k]); }
            __syncthreads();
            const float* w = in[2] + ((size_t)l * D + (size_t)kc * 64) * (6 * D) + nh * (3 * D);
            f32x4 acc[3][4];
#pragma unroll
            for (int j = 0; j < 3; ++j)
#pragma unroll
                for (int b = 0; b < 4; ++b) acc[j][b] = (f32x4){0.f, 0.f, 0.f, 0.f};
#pragma unroll 8
            for (int k = 0; k < 64; ++k) { const f32x4 cb = *(const LAS f32x4*)(ca + 4 * k);
#pragma unroll
                for (int j = 0; j < 3; ++j) { const f32x4 wv = *(const f32x4*)(w + (size_t)k * (6 * D) + 4 * (tid + 512 * j));
                    acc[j][0] += wv * cb.x; acc[j][1] += wv * cb.y; acc[j][2] += wv * cb.z; acc[j][3] += wv * cb.w; } }
            float* mp = (float*)(wsl + O_MODP) + ((size_t)kc * L + l) * NB * (6 * D) + nh * (3 * D);
#pragma unroll
            for (int j = 0; j < 3; ++j)
#pragma unroll
                for (int b = 0; b < 4; ++b) *(f32x4*)(mp + (size_t)b * (6 * D) + 4 * (tid + 512 * j)) = acc[j][b];
        }
        __syncthreads();
    }
    for (int c = cid * NTHR_C + tid; c < DH; c += G * NTHR_C) {
        float v[L], mx = -1e30f;
#pragma unroll
        for (int l = 0; l < L; ++l) { v[l] = in[6][l * DH + c]; mx = fmaxf(mx, v[l]); }
        float s_ = 0.f;
#pragma unroll
        for (int l = 0; l < L; ++l) { v[l] = __expf(v[l] - mx); s_ += v[l]; }
        const float p0 = v[0] / s_; float cum = 0.f;
#pragma unroll
        for (int l = 0; l < L; ++l) { cum += v[l] / s_; ((float*)(wsl + O_LB))[l * DH + c] = fminf(fmaxf(cum - p0, 0.f), 1.f); }
    }
    {   LAS float* scr = (LAS float*)(lds + wave * 16384);
        constexpr int SEG = 8, I_OUT = (D / 64 / SEG) * (D / 32), I_DN = (DFF / 64 / SEG) * (D / 32);
        static_assert((D / 64) % SEG == 0 && (DFF / 64) % SEG == 0, "segments");
        for (int it = cid * 8 + wave; it < L * (I_OUT + I_DN); it += G * 8) { const int l = it / (I_OUT + I_DN), r = it % (I_OUT + I_DN);
            if (r < I_OUT) { const int sg = r / (D / 32), nb = r % (D / 32); wt_col_item<false, true>(in[10] + (size_t)l * D * D, D, (bf16_t*)(wsl + O_WTOUT) + (size_t)l * D * D, D, sg * SEG, sg * SEG + SEG, false, scr, nb, lane, nullptr, nullptr); }
            else { const int r2 = r - I_OUT, sg = r2 / (D / 32), nb = r2 % (D / 32); wt_col_item<false, true>(in[15] + (size_t)l * DFF * D, D, (bf16_t*)(wsl + O_WTDN) + (size_t)l * D * DFF, DFF, sg * SEG, sg * SEG + SEG, false, scr, nb, lane, nullptr, nullptr); } } }
    for (int i = cid * NTHR_C + tid; i < L * 4 * 256 * 256 / 8; i += G * NTHR_C) { const int e0 = (i & 31) * 8, lg = i >> 13;
        const f32x4 a0 = *(const f32x4*)(in[8] + (size_t)i * 8), a1 = *(const f32x4*)(in[8] + (size_t)i * 8 + 4);
        const f32x4 s0 = *(const f32x4*)(in[9] + lg * 256 + e0), s1 = *(const f32x4*)(in[9] + lg * 256 + e0 + 4);
        u32x4 o; o.x = cvt_pk_bf16_c(a0.x * s0.x, a0.y * s0.y); o.y = cvt_pk_bf16_c(a0.z * s0.z, a0.w * s0.w); o.z = cvt_pk_bf16_c(a1.x * s1.x, a1.y * s1.y); o.w = cvt_pk_bf16_c(a1.z * s1.z, a1.w * s1.w);
        *(u32x4*)((bf16_t*)(wsl + O_WTPL) + (size_t)i * 8) = o; }
}
__device__ __forceinline__ void pro_b(const float* const* in, unsigned char* wsl, int cid, int G, int tid) {
    const float* mp = (const float*)(wsl + O_MODP); float* MOD = (float*)(wsl + O_MOD);
    for (int i = cid * NTHR_C + tid; i < L * NB * 6 * D; i += G * NTHR_C) {
        const int l = i / (NB * 6 * D), n = i % (6 * D); float a = in[3][l * 6 * D + n];
#pragma unroll 8
        for (int kc = 0; kc < MOD_KC; ++kc) a += mp[(size_t)kc * (L * NB * 6 * D) + i];
        MOD[i] = a; }
}
__device__ __forceinline__ void pro_c(LAS unsigned char* lds, const float* const* in, unsigned char* wsl, int cid, int G, int tid) {
    const int wave = __builtin_amdgcn_readfirstlane(tid >> 6), lane = tid & 63;
    const float* MOD = (const float*)(wsl + O_MOD);
    for (int i = cid * NTHR_C + tid; i < L * NB * D; i += G * NTHR_C) { const int k = i % D, lb = i / D, l = lb / NB;
        ((float*)(wsl + O_GS1))[i] = in[4][l * D + k] * (1.f + MOD[(size_t)lb * 6 * D + D + k]);
        ((float*)(wsl + O_GS2))[i] = in[11][l * D + k] * (1.f + MOD[(size_t)lb * 6 * D + 4 * D + k]); }
    {   LAS float* scr = (LAS float*)(lds + wave * 16384); constexpr int CI = DIN / 32 + NUP / 32;
        for (int it = cid * 8 + wave; it < L * CI; it += G * 8) { const int l = it / CI, r = it % CI;
            if (r < DIN / 32) wt_col_item<true, true>(in[5] + (size_t)l * D * DIN, DIN, (bf16_t*)(wsl + O_WTIN) + (size_t)l * DIN * D, D, 0, D / 64, false, scr, r, lane, MOD + (size_t)l * NB * 6 * D, (float*)(wsl + O_SW1) + (size_t)l * NB * DIN);
            else wt_col_item<true, true>(in[12] + (size_t)l * D * NUP, NUP, (bf16_t*)(wsl + O_WTUP) + (size_t)l * NUP * D, D, 0, D / 64, true, scr, r - DIN / 32, lane, MOD + (size_t)l * NB * 6 * D + 3 * D, (float*)(wsl + O_SW2) + (size_t)l * NB * NUP); } }
    for (int row = cid * 8 + wave; row < M; row += G * 8) { const int b = row / SEQ;
        const float* xr = in[0] + (size_t)row * D; bf16_t* xs = (bf16_t*)(wsl + O_XS); float* rss = (float*)(wsl + O_RSS1) + (size_t)row * 32;
#pragma unroll
        for (int j = 0; j < 8; ++j) { const int c = 4 * lane + 256 * j; const f32x4 v = *(const f32x4*)(xr + c);
            const f32x4 g = *(const f32x4*)(in[4] + c), sc = *(const f32x4*)(MOD + (size_t)b * 6 * D + D + c);
            u32x2 o; o.x = cvt_pk_bf16_c(v.x * (g.x * (1.f + sc.x)), v.y * (g.y * (1.f + sc.y))); o.y = cvt_pk_bf16_c(v.z * (g.z * (1.f + sc.z)), v.w * (g.w * (1.f + sc.w)));
            *(u32x2*)(xs + xs_off(row, c)) = o;
            float ss = (v.x * v.x + v.y * v.y) + (v.z * v.z + v.w * v.w);
            ss += bperm(ss, lane ^ 1); ss += bperm(ss, lane ^ 2); ss += bperm(ss, lane ^ 4); ss += bperm(ss, lane ^ 8);
            if ((lane & 15) == 0) rss[4 * j + (lane >> 4)] = ss; }
    }
}

#define XB_TMO      128
#define XB_XCNT(j)  (256  + 64 * (j))
#define XB_XSUB(j)  (1280 + 64 * (j))
#define XB_XGEN(j)  (2304 + 64 * (j))
#define XB_TOP      3328
#define XB_TOPGEN   3392
#define XCD_BAR_WORDS 3456
#define XB_SPIN_CAP (1u << 18)
__device__ __forceinline__ unsigned xb_ld(unsigned* p)              { return __hip_atomic_load(p, __ATOMIC_RELAXED, __HIP_MEMORY_SCOPE_AGENT); }
__device__ __forceinline__ unsigned xb_add(unsigned* p, unsigned v) { return __hip_atomic_fetch_add(p, v, __ATOMIC_RELAXED, __HIP_MEMORY_SCOPE_AGENT); }
__device__ __forceinline__ unsigned xb_xcc_id() { return (unsigned)__builtin_amdgcn_s_getreg((3 << 11) | 20) & 0xFu; }
#define XB_SPIN(cond, bar) do { unsigned _sp = 0; while (cond) { __builtin_amdgcn_s_sleep(1); \
    if ((++_sp & 255u) == 0u) { if (xb_ld(&(bar)[XB_TMO])) break; if (_sp > XB_SPIN_CAP) { atomicAdd(&(bar)[XB_TMO], 1u); break; } } } } while (0)
struct XcdBarrier { unsigned* bar; unsigned x; volatile LAS unsigned* st; bool t0; };
__device__ __forceinline__ XcdBarrier xcd_barrier_post(unsigned* bar, volatile LAS unsigned* st, bool t0) {
    XcdBarrier b; b.bar = bar; b.x = xb_xcc_id(); b.st = st; b.t0 = t0;
    if (b.t0) (void)xb_add(&bar[XB_XCNT(b.x)], 1u);
    return b;
}
__device__ __forceinline__ void xcd_barrier_complete(unsigned* bar, unsigned x, unsigned& nloc, unsigned& nx) {
    const unsigned G = gridDim.x * gridDim.y * gridDim.z;
    unsigned sum, cnt, mine, sp = 0u;
    for (;;) {
        sum = 0u; cnt = 0u; mine = 0u;
#pragma unroll
        for (unsigned j = 0; j < 16; ++j) { const unsigned c = xb_ld(&bar[XB_XCNT(j)]); sum += c; cnt += (c > 0u) ? 1u : 0u; mine = (j == x) ? c : mine; }
        if (sum == G) break;
        __builtin_amdgcn_s_sleep(1);
        if ((++sp & 255u) == 0u) { if (xb_ld(&bar[XB_TMO])) break; if (sp > XB_SPIN_CAP) { atomicAdd(&bar[XB_TMO], 1u); break; } }
    }
    nloc = mine > 0u ? mine : 1u; nx = cnt > 0u ? cnt : 1u;
}
__device__ __forceinline__ void xcd_barrier(const XcdBarrier& b) {
    asm volatile("s_waitcnt vmcnt(0)" ::: "memory");
    __syncthreads();
    if (b.t0) {
        unsigned* bar = b.bar;
        __builtin_amdgcn_s_waitcnt(0);
        unsigned nloc = b.st[0], nx = b.st[1];
        if (nloc == 0u) { xcd_barrier_complete(bar, b.x, nloc, nx); b.st[0] = nloc; b.st[1] = nx; }
        const unsigned old = xb_add(&bar[XB_XSUB(b.x)], 1u);
        const unsigned gen = old / nloc;
        if (old + 1u == (gen + 1u) * nloc) {
            __builtin_amdgcn_fence(__ATOMIC_RELEASE, "agent");
            asm volatile("s_waitcnt vmcnt(0)" ::: "memory");
            const unsigned og = xb_add(&bar[XB_TOP], 1u);
            const unsigned tg = og / nx;
            if (og + 1u == (tg + 1u) * nx) xb_add(&bar[XB_TOPGEN], 1u);
            else XB_SPIN(xb_ld(&bar[XB_TOPGEN]) == tg, bar);
            __builtin_amdgcn_fence(__ATOMIC_ACQUIRE, "agent");
            xb_add(&bar[XB_XGEN(b.x)], 1u);
            asm volatile("s_waitcnt vmcnt(0)" ::: "memory");
        } else {
            XB_SPIN(xb_ld(&bar[XB_XGEN(b.x)]) == gen, bar);
            __builtin_amdgcn_fence(__ATOMIC_ACQUIRE, "agent");
            asm volatile("s_waitcnt vmcnt(0)" ::: "memory");
        }
    }
    __syncthreads();
}

__device__ __forceinline__ void group_barrier(unsigned* ctl, int cid, int G, bool t0, volatile LAS unsigned* misc) {
    asm volatile("s_waitcnt vmcnt(0)" ::: "memory");
    __syncthreads();
    if (t0) {
        unsigned* cnt = ctl + 8192 + 64 * (cid & 7); unsigned* xid = ctl + 8192 + 1024; unsigned* tmo = ctl + 4096 + XB_TMO;
        unsigned st = misc[0];
        if (st == 0u) { const unsigned mine = xb_ld(&xid[cid]); bool same = true; for (int j = (cid & 7); j < G; j += 8) same = same && (xb_ld(&xid[j]) == mine); st = same ? 1u : 2u; misc[0] = st; }
        if (st != 1u) { __builtin_amdgcn_fence(__ATOMIC_RELEASE, "agent"); asm volatile("s_waitcnt vmcnt(0)" ::: "memory"); }
        const unsigned n = (unsigned)((G - (cid & 7) + 7) / 8);
        const unsigned old = xb_add(cnt, 1u), target = (old / n + 1u) * n; unsigned sp = 0u;
        while (xb_ld(cnt) < target) { __builtin_amdgcn_s_sleep(1); if ((++sp & 255u) == 0u) { if (xb_ld(tmo)) break; if (sp > XB_SPIN_CAP) { atomicAdd(tmo, 1u); break; } } }
        __builtin_amdgcn_fence(__ATOMIC_ACQUIRE, "agent");
        asm volatile("s_waitcnt vmcnt(0)" ::: "memory");
    }
    __syncthreads();
}

__device__ __forceinline__ void team_barrier(unsigned* ctl, int cid, int G, bool t0, volatile LAS unsigned* misc) {
    asm volatile("s_waitcnt vmcnt(0)" ::: "memory");
    __syncthreads();
    if (t0) {
        unsigned* xid = ctl + 8192 + 1024; unsigned* tmo = ctl + 4096 + XB_TMO;
        unsigned st = misc[0];
        if (st == 0u) { const unsigned mine = xb_ld(&xid[cid]); bool same = true; for (int j = (cid & 7); j < G; j += 8) same = same && (xb_ld(&xid[j]) == mine); st = same ? 1u : 2u; misc[0] = st; }
        const int vidq = 32 * (cid & 7) + (cid >> 3), T = ((vidq >> 2) >> 4) * 4 + (vidq & 3), xh = cid & 1;
        unsigned* tb = ctl + 16384 + 256 * T;
        if (st != 1u) { __builtin_amdgcn_fence(__ATOMIC_RELEASE, "agent"); asm volatile("s_waitcnt vmcnt(0)" ::: "memory"); }
        const unsigned old = xb_add(tb + 64 * xh, 1u), g = old / 8u;
        if (old + 1u == (g + 1u) * 8u) {
            if (st == 1u) { __builtin_amdgcn_fence(__ATOMIC_RELEASE, "agent"); asm volatile("s_waitcnt vmcnt(0)" ::: "memory"); }
            const unsigned ot = xb_add(tb + 128, 1u);
            if (ot + 1u == (g + 1u) * 2u) xb_add(tb + 192, 1u);
        }
        unsigned sp = 0u;
        while (xb_ld(tb + 192) <= g) { __builtin_amdgcn_s_sleep(1); if ((++sp & 255u) == 0u) { if (xb_ld(tmo)) break; if (sp > XB_SPIN_CAP) { atomicAdd(tmo, 1u); break; } } }
        __builtin_amdgcn_fence(__ATOMIC_ACQUIRE, "agent");
        asm volatile("s_waitcnt vmcnt(0)" ::: "memory");
    }
    __syncthreads();
}

constexpr int NWAVES = 8, NTHR = NWAVES * 64;
constexpr int RING_BYTES = 131072, LDS_BYTES = 163840, MISC_OFF = LDS_BYTES - 256;
constexpr int CW_BAR = 4096;
enum { PH_PRO_A = 0, PH_PRO_B = 1, PH_PRO_C = 2, PH_LAYER0 = 3, PH_PER_LAYER = 8, PH_FINAL = PH_LAYER0 + PH_PER_LAYER * L, NPHASE = PH_FINAL + 1 };
enum { LP_IN = 0, LP_H1 = 1, LP_H2 = 2, LP_H3 = 3, LP_OUT = 4, LP_UP = 5, LP_FIX = 6, LP_DOWN = 7 };
struct MKArgs { const float* in[17]; float* out; unsigned char* ws; int ph_lo, ph_hi; };
static_assert(sizeof(MKArgs) == 19 * 8 + 8, "MKArgs has no padding");

__global__ void __launch_bounds__(NTHR, 2) mk_fwd(MKArgs args) {
    extern __shared__ __attribute__((aligned(16))) unsigned char lds_raw[];
    LAS unsigned char* lds = (LAS unsigned char*)lds_raw;
    volatile LAS unsigned* MISC = (volatile LAS unsigned*)(lds + MISC_OFF);
    const int wid_s = __builtin_amdgcn_readfirstlane((int)threadIdx.x >> 6), G = gridDim.x;
#define MK_TID() (wid_s * 64 + lane_id_opaque())
    unsigned char* ws = args.ws;
    for (int u = MK_TID(); u < (LDS_BYTES - RING_BYTES) / 4; u += NTHR) ((LAS unsigned*)(lds + RING_BYTES))[u] = 0u;
    __syncthreads();
    const int lo = args.ph_lo, hi = args.ph_hi;
    XcdBarrier bar; bar.bar = (unsigned*)(ws + O_CTL) + CW_BAR; bar.x = 0; bar.st = nullptr; bar.t0 = false;
    if (hi - lo > 1) bar = xcd_barrier_post((unsigned*)(ws + O_CTL) + CW_BAR, MISC + 8, MK_TID() == 0);
    if (MK_TID() == 0) __hip_atomic_store((unsigned*)(ws + O_CTL) + 8192 + 1024 + blockIdx.x, xb_xcc_id(), __ATOMIC_RELAXED, __HIP_MEMORY_SCOPE_AGENT);
#define IN(k) (lo <= (k) && (k) < hi)
#define SEAM(k) do { if ((k) + 1 < hi) { XcdBarrier bl_ = bar; asm volatile("" : "+s"(bl_.bar), "+s"(bl_.x)); bl_.t0 = (MK_TID() == 0); xcd_barrier(bl_); } } while (0)
#define GSEAM(k) do { if ((k) + 1 < hi) { if (G == 256) { unsigned* gc_ = (unsigned*)(ws + O_CTL); int cq_ = (int)blockIdx.x; asm volatile("" : "+s"(gc_), "+s"(cq_)); \
        group_barrier(gc_, cq_, G, MK_TID() == 0, MISC + 12); } else SEAM(k); } } while (0)
#define TSEAM(k) do { if ((k) + 1 < hi) { if (G == 256) { unsigned* gc_ = (unsigned*)(ws + O_CTL); int cq_ = (int)blockIdx.x; asm volatile("" : "+s"(gc_), "+s"(cq_)); \
        team_barrier(gc_, cq_, G, MK_TID() == 0, MISC + 12); } else SEAM(k); } } while (0)
#define PHASE_OPAQUE() size_t zoff_ = 0; int cid = (int)blockIdx.x; asm volatile("" : "+s"(zoff_), "+s"(cid)); unsigned char* wsl = ws + zoff_; const int tid = MK_TID()
    if (IN(PH_PRO_A)) { PHASE_OPAQUE(); pro_a(lds, args.in, wsl, cid, G, tid); SEAM(PH_PRO_A); }
    if (IN(PH_PRO_B)) { PHASE_OPAQUE(); pro_b(args.in, wsl, cid, G, tid);
        pg8::Gemm g{(const bf16_t*)(wsl + O_WTOUT) + 16 * 256 * 64, (const bf16_t*)(wsl + O_WTPL)}; FoldOrder S; S.init(G, cid);
        EpiFold E{(bf16_t*)(wsl + O_WTOUT)};
        pg8::gemm_phase<EpiFold, FoldOrder, 64, 256, 256, 4 * 256 * 64 * 2, PG8_ALIGN, PG8_SP2, false, pg8::NoPre, 256 * 64 * 2, (long)256 * D * 2>(lds, g, S, E, tid);
        SEAM(PH_PRO_B); }
    if (IN(PH_PRO_C)) { PHASE_OPAQUE(); pro_c(lds, args.in, wsl, cid, G, tid); SEAM(PH_PRO_C); }
    for (int l = 0; l < L; ++l) {
        const int base = PH_LAYER0 + PH_PER_LAYER * l;
        if (IN(base + LP_IN)) {
            PHASE_OPAQUE();
            pg8::Gemm g{(const bf16_t*)(wsl + O_XS), (const bf16_t*)(wsl + O_WTIN) + (size_t)l * DIN * D}; pg8::InOrder S; S.init(G, cid);
            const FillRstd<pg8::InOrder> FR{lds, (const float*)(wsl + O_RSS1), &S, tid};
            EpiIn E{(const LAS float*)(lds + RSTD_OFF), (const float*)(wsl + O_SW1) + (size_t)l * NB * DIN, (const float*)(wsl + O_LB) + l * DH,
                    (bf16_t*)(wsl + O_Q), (bf16_t*)(wsl + O_V), (bf16_t*)(wsl + O_SG), (bf16_t*)(wsl + O_U), (_Float16*)(wsl + O_LF)};
            pg8::gemm_phase<EpiIn, pg8::InOrder, 64, 64, D, 0, PG8_ALIGN, PG8_SP2, false, FillRstd<pg8::InOrder>, 256 * 64 * 2, (long)256 * D * 2, false, 256 * 64 * 2, (long)256 * D * 2>(lds, g, S, E, tid, FR);
            hgrn_h1(lds, (const _Float16*)(wsl + O_LF), (const bf16_t*)(wsl + O_V), (bf16_t*)(wsl + O_DS), (float*)(wsl + O_DEC), S, tid);
            TSEAM(base + LP_IN);
        }
        if (IN(base + LP_H1)) {
            PHASE_OPAQUE();
            pool_elem((const bf16_t*)(wsl + O_U), (bf16_t*)(wsl + O_YAB), 64, cid, G, tid);
            hgrn_h2(lds, (bf16_t*)(wsl + O_DS), (const float*)(wsl + O_DEC), cid, G, tid);
            TSEAM(base + LP_H1);
        }
        if (IN(base + LP_H3)) {
            PHASE_OPAQUE();
            hgrn_h3(lds, (const bf16_t*)(wsl + O_Q), (const _Float16*)(wsl + O_LF), (const bf16_t*)(wsl + O_V), (const bf16_t*)(wsl + O_SG), (const bf16_t*)(wsl + O_DS), args.in[7] + l * HD, (bf16_t*)(wsl + O_YAB), cid, G, tid);
            GSEAM(base + LP_H3);
        }
        if (IN(base + LP_OUT)) {
            PHASE_OPAQUE();
            pg8::Gemm g{(const bf16_t*)(wsl + O_YAB), (const bf16_t*)(wsl + O_WTOUT) + (size_t)l * D * D}; pg8::StaticOrder S; S.init(M, D, G, cid, 4);
            bf16_t* X = (bf16_t*)(wsl + O_X);
            EpiRes E{l == 0 ? (const void*)args.in[0] : (const void*)X, X, (const float*)(wsl + O_MOD) + (size_t)l * NB * 6 * D + 2 * D, (const float*)(wsl + O_GS2) + (size_t)l * NB * D, (bf16_t*)(wsl + O_XS), (float*)(wsl + O_RSS2), l == 0 ? 1 : 0, 0};
            pg8::gemm_phase<EpiRes, pg8::StaticOrder, 64, 64, D, 0, PG8_ALIGN, PG8_SP2, false, pg8::NoPre, 256 * 64 * 2, (long)256 * D * 2, false, 256 * 64 * 2, (long)256 * D * 2>(lds, g, S, E, tid);
            GSEAM(base + LP_OUT);
        }
        if (IN(base + LP_UP)) {
            PHASE_OPAQUE();
            pg8::Gemm g{(const bf16_t*)(wsl + O_XS), (const bf16_t*)(wsl + O_WTUP) + (size_t)l * NUP * D}; pg8::StaticOrder S; S.init(M, NUP, G, cid);
            const FillRstd<pg8::StaticOrder> FR{lds, (const float*)(wsl + O_RSS2), &S, tid};
            EpiUp E{(const LAS float*)(lds + RSTD_OFF), (const float*)(wsl + O_SW2) + (size_t)l * NB * NUP, args.in[13] + (size_t)l * 3 * DFF, args.in[14] + (size_t)l * DFF, (bf16_t*)(wsl + O_ACT), (float*)(wsl + O_HA), (float*)(wsl + O_HV)};
            pg8::gemm_phase<EpiUp, pg8::StaticOrder, 64, 64, D, 0, PG8_ALIGN, PG8_SP2, true, FillRstd<pg8::StaticOrder>, 256 * 64 * 2, (long)256 * D * 2, false, 256 * 64 * 2, (long)256 * D * 2>(lds, g, S, E, tid, FR);
            SEAM(base + LP_UP);
        }
        if (IN(base + LP_FIX)) {
            PHASE_OPAQUE();
            const float* cw = args.in[13] + (size_t)l * 3 * DFF; const float* cb = args.in[14] + (size_t)l * DFF;
            const float* HA = (const float*)(wsl + O_HA); const float* HV = (const float*)(wsl + O_HV); bf16_t* ACT = (bf16_t*)(wsl + O_ACT);
            const bool byg = (G == 256);
            for (int it = byg ? (cid >> 3) * NTHR + tid : cid * NTHR + tid; it < (byg ? 16 : 128) * (DFF / 4); it += (byg ? 32 : G) * NTHR) {
                const int kb = (byg ? 16 * (cid & 7) : 0) + it / (DFF / 4), j = (it % (DFF / 4)) * 4; if ((kb & 31) == 0) continue;
                const f32x4 am2 = *(const f32x4*)(HA + ((size_t)(kb - 1) * 4 + 2) * DFF + j), am1 = *(const f32x4*)(HA + ((size_t)(kb - 1) * 4 + 3) * DFF + j);
                const f32x4 a0 = *(const f32x4*)(HA + ((size_t)kb * 4 + 0) * DFF + j), a1 = *(const f32x4*)(HA + ((size_t)kb * 4 + 1) * DFF + j);
                const f32x4 v0 = *(const f32x4*)(HV + ((size_t)kb * 2 + 0) * DFF + j), v1 = *(const f32x4*)(HV + ((size_t)kb * 2 + 1) * DFF + j);
                const f32x4 cbv = *(const f32x4*)(cb + j), w0 = *(const f32x4*)(cw + j), w1 = *(const f32x4*)(cw + DFF + j), w2 = *(const f32x4*)(cw + 2 * DFF + j);
                const f32x4 c0 = cbv + w0 * am2 + w1 * am1 + w2 * a0, c1 = cbv + w0 * am1 + w1 * a0 + w2 * a1;
                const f32x4 o0 = silu4(c0) * v0, o1 = silu4(c1) * v1;
                u32x2 p0, p1; p0.x = cvt_pk_bf16(o0.x, o0.y); p0.y = cvt_pk_bf16(o0.z, o0.w); p1.x = cvt_pk_bf16(o1.x, o1.y); p1.y = cvt_pk_bf16(o1.z, o1.w);
                bf16_t* ap = ACT + (size_t)(kb >> 1) * (256 * DFF) + (size_t)(j >> 6) * (256 * 64) + (128 * (kb & 1)) * 64 + (j & 63);
                *(u32x2*)ap = p0; *(u32x2*)(ap + 64) = p1;
            }
            GSEAM(base + LP_FIX);
        }
        if (IN(base + LP_DOWN)) {
            PHASE_OPAQUE();
            pg8::Gemm g{(const bf16_t*)(wsl + O_ACT), (const bf16_t*)(wsl + O_WTDN) + (size_t)l * D * DFF}; pg8::StaticOrder S; S.init(M, D, G, cid, 4);
            const bool lastl = (l == L - 1); bf16_t* X = (bf16_t*)(wsl + O_X);
            EpiRes E{X, (void*)X, (const float*)(wsl + O_MOD) + (size_t)l * NB * 6 * D + 5 * D, (const float*)(wsl + O_GS1) + (size_t)(lastl ? 0 : l + 1) * NB * D, lastl ? (bf16_t*)nullptr : (bf16_t*)(wsl + O_XS), (float*)(wsl + O_RSS1), 0, 0};
            pg8::gemm_phase<EpiRes, pg8::StaticOrder, 64, 64, DFF, 0, PG8_ALIGN, PG8_SP2, false, pg8::NoPre, 256 * 64 * 2, (long)256 * DFF * 2, true, 256 * 64 * 2, (long)256 * DFF * 2>(lds, g, S, E, tid);
            if (l + 1 < L) GSEAM(base + LP_DOWN); else SEAM(base + LP_DOWN);
        }
    }
    if (IN(PH_FINAL)) {
        PHASE_OPAQUE();
        const float* RSS1 = (const float*)(wsl + O_RSS1); const float* fin_g = args.in[16]; const bf16_t* X = (const bf16_t*)(wsl + O_X);
        const int lane = tid & 63, wv = wid_s;
        for (int row = cid * NWAVES + wv; row < M; row += G * NWAVES) {
            float s = (lane < 32) ? RSS1[(size_t)row * 32 + lane] : 0.f;
#pragma unroll
            for (int o = 32; o >= 1; o >>= 1) s += bperm(s, lane ^ o);
            const float r = rsqrtf(s * (1.f / D) + EPS);
            float* orow = args.out + (size_t)row * D; const bf16_t* xrow = X + (size_t)row * D;
#pragma unroll
            for (int j = 0; j < 4; ++j) { const int c = j * 512 + lane * 8; const f16x8_t hh = *(const f16x8_t*)(xrow + c); const f32x8_t ff = __builtin_convertvector(hh, f32x8_t);
                const f32x4 g0 = *(const f32x4*)(fin_g + c), g1 = *(const f32x4*)(fin_g + c + 4);
                *(f32x4*)(orow + c) = (f32x4){ff[0], ff[1], ff[2], ff[3]} * r * g0; *(f32x4*)(orow + c + 4) = (f32x4){ff[4], ff[5], ff[6], ff[7]} * r * g1; }
        }
    }
#undef PHASE_OPAQUE
#undef IN
#undef SEAM
}

static void mk_launch(const MKArgs& base, int lo, int hi, int grid, hipStream_t stream) {
    MKArgs a = base; a.ph_lo = lo; a.ph_hi = hi;
    hipLaunchKernelGGL(mk_fwd, dim3(grid), dim3(NTHR), LDS_BYTES, stream, a);
}

extern "C" void kernel_launch(void* const* d_in, const int* in_sizes, int n_in, void* d_out, int out_size, void* d_ws, size_t ws_size, hipStream_t stream) {
    static int grid = 0;
    if (grid == 0) {
        if (n_in != 17 || ws_size < WS_END) { fprintf(stderr, "kernel_launch: unexpected n_in %d or ws_size %zu < %zu\n", n_in, ws_size, (size_t)WS_END); grid = -1; return; }
        int dev = 0, cus = 0;
        if (hipGetDevice(&dev) != hipSuccess || hipDeviceGetAttribute(&cus, hipDeviceAttributeMultiprocessorCount, dev) != hipSuccess) { grid = -1; return; }
        if (hipFuncSetAttribute((const void*)mk_fwd, hipFuncAttributeMaxDynamicSharedMemorySize, LDS_BYTES) != hipSuccess) { fprintf(stderr, "kernel_launch: hipFuncSetAttribute failed\n"); grid = -1; return; }
        int per_cu = 0; (void)hipOccupancyMaxActiveBlocksPerMultiprocessor(&per_cu, (const void*)mk_fwd, NTHR, LDS_BYTES); (void)hipGetLastError();
        grid = cus;
    }
    if (grid < 0) return;
    char* ws = (char*)d_ws; float* out = (float*)d_out;
    (void)hipMemsetAsync(ws + O_CTL, 0, SZ_CTL, stream);
    MKArgs a{}; for (int i = 0; i < 17; ++i) a.in[i] = (const float*)d_in[i]; a.out = out; a.ws = (unsigned char*)d_ws;

    mk_launch(a, 0, NPHASE, grid, stream);
}
```
